# Optimizing an MI355X kernel written in HIP

```python
import math
import jax, jax.numpy as jnp
from jax import lax
import numpy as np

D_MODEL = 1024
BATCH = 2
SEQ = 16384
DEPTH = 2

N_A = DEPTH // 2
N_B = DEPTH - N_A

HEAD_DIM = 64
MIX_W = D_MODEL
MEM_HEADS = 4
MEM_W = MEM_HEADS * HEAD_DIM
REC_W = MIX_W - MEM_W
REC_BLOCKS = REC_W // HEAD_DIM
SB_W = MIX_W - MEM_W
SB_HEADS = SB_W // HEAD_DIM
N_MEM = 256
CONV_W = 4
LRU_C = 8.0
D_FF = 2816
Q_BLOCK = 128
EPS = 1e-6

kernel_name = "yoco_rglru_stickbreaking_hybrid"


def rms_norm(x, g):
    xf = x.astype(jnp.float32)
    y = xf * lax.rsqrt(jnp.mean(xf * xf, axis=-1, keepdims=True) + EPS)
    return (y * g.astype(jnp.float32)).astype(x.dtype)


def swiglu(h, w_gate, w_up, w_down):
    return (jax.nn.silu(h @ w_gate) * (h @ w_up)) @ w_down


def causal_depthwise_conv(x, w, b):
    c = x.shape[-1]
    y = lax.conv_general_dilated(
        x, w[:, None, :].astype(x.dtype), window_strides=(1,),
        padding=[(CONV_W - 1, 0)], dimension_numbers=("NWC", "WIO", "NWC"),
        feature_group_count=c)
    return y + b


def rg_lru(xc, gate_w, gate_b, lam):
    bsz, s, _ = xc.shape
    xf = xc.astype(jnp.float32)
    xb = xf.reshape(bsz, s, REC_BLOCKS, HEAD_DIM)
    gates = jnp.einsum("bsnc,gncd->gbsnd", xb, gate_w.astype(jnp.float32))
    gates = gates.reshape(2, bsz, s, REC_W) + gate_b.astype(jnp.float32)[:, None, None, :]
    r = jax.nn.sigmoid(gates[0])
    i = jax.nn.sigmoid(gates[1])
    log_a = -LRU_C * r * jax.nn.softplus(-lam.astype(jnp.float32))
    a = jnp.exp(log_a)
    b = jnp.sqrt(-jnp.expm1(2.0 * log_a)) * (i * xf)

    def combine(c1, c2):
        a1, b1 = c1
        a2, b2 = c2
        return a1 * a2, a2 * b1 + b2

    _, h = lax.associative_scan(combine, (a, b), axis=1)
    return h.astype(xc.dtype)


def stick_breaking_attention(q, k, v):
    dtype = q.dtype
    q = q.astype(jnp.float32) * (1.0 / math.sqrt(HEAD_DIM))
    k = k.astype(jnp.float32)
    v = v.astype(jnp.float32)
    bsz, nh, s, dh = q.shape
    n_blk = s // Q_BLOCK
    ar = jnp.arange(Q_BLOCK)

    def q_block(qb):
        q_blk = lax.dynamic_slice_in_dim(q, qb * Q_BLOCK, Q_BLOCK, axis=2)
        t_idx = qb * Q_BLOCK + ar

        def body(i, carry):
            acc, log_rest = carry
            kb = qb - i
            k_blk = lax.dynamic_slice_in_dim(k, kb * Q_BLOCK, Q_BLOCK, axis=2)
            v_blk = lax.dynamic_slice_in_dim(v, kb * Q_BLOCK, Q_BLOCK, axis=2)
            z = jnp.einsum("bhqd,bhkd->bhqk", q_blk, k_blk)
            causal = (kb * Q_BLOCK + ar)[None, :] < t_idx[:, None]
            log_1mb = jnp.where(causal, jax.nn.log_sigmoid(-z), 0.0)
            suffix = lax.cumsum(log_1mb, axis=3, reverse=True) - log_1mb
            log_w = jax.nn.log_sigmoid(z) + suffix + log_rest[..., None]
            w = jnp.where(causal, jnp.exp(log_w), 0.0)
            acc = acc + jnp.einsum("bhqk,bhkd->bhqd", w, v_blk)
            log_rest = log_rest + jnp.sum(log_1mb, axis=3)
            return acc, log_rest

        init = (jnp.zeros((bsz, nh, Q_BLOCK, dh), jnp.float32),
                jnp.zeros((bsz, nh, Q_BLOCK), jnp.float32))
        acc, _ = lax.fori_loop(0, qb + 1, body, init)
        return acc

    out = lax.map(q_block, jnp.arange(n_blk))
    out = out.transpose(1, 0, 3, 2, 4).reshape(bsz, s, nh * dh)
    return out.astype(dtype)


def memory_attention(q_mem, mem_n, w_mem_kv):
    bsz, s, _ = q_mem.shape
    q = q_mem.reshape(bsz, s, MEM_HEADS, HEAD_DIM).astype(jnp.float32)
    kv = (mem_n @ w_mem_kv).reshape(bsz, N_MEM, 2, MEM_HEADS, HEAD_DIM).astype(jnp.float32)
    scores = jnp.einsum("bshd,bmhd->bhsm", q, kv[:, :, 0]) * (1.0 / math.sqrt(HEAD_DIM))
    p = jax.nn.softmax(scores, axis=-1)
    out = jnp.einsum("bhsm,bmhd->bshd", p, kv[:, :, 1])
    return out.reshape(bsz, s, MEM_W).astype(q_mem.dtype)


def setup_inputs(seed: int = 0) -> dict:
    key = jax.random.key(seed)
    ks = jax.random.split(key, 20)
    nrm = jax.random.normal
    d = D_MODEL
    x = nrm(ks[0], (BATCH, SEQ, d), jnp.float32)
    mem = nrm(ks[1], (BATCH, N_MEM, d), jnp.float32)
    ffn_w_gate = nrm(ks[2], (DEPTH, 2, d, D_FF), jnp.float32) * d ** -0.5
    ffn_w_up = nrm(ks[3], (DEPTH, 2, d, D_FF), jnp.float32) * d ** -0.5
    ffn_w_down = nrm(ks[4], (DEPTH, 2, D_FF, d), jnp.float32) * D_FF ** -0.5
    norm_g = 1.0 + 0.1 * nrm(ks[5], (DEPTH, 6, d), jnp.float32)
    mem_norm_g = 1.0 + 0.1 * nrm(ks[6], (DEPTH, d), jnp.float32)
    w_mem_kv = nrm(ks[7], (DEPTH, d, 2 * MEM_W), jnp.float32) * d ** -0.5
    w_mix_out = nrm(ks[8], (DEPTH, MIX_W, d), jnp.float32) * MIX_W ** -0.5
    a_w_in = nrm(ks[9], (N_A, d, 2 * REC_W + MEM_W), jnp.float32) * d ** -0.5
    a_conv_w = nrm(ks[10], (N_A, CONV_W, REC_W), jnp.float32) * CONV_W ** -0.5
    a_conv_b = 0.01 * nrm(ks[11], (N_A, REC_W), jnp.float32)
    a_gate_w = nrm(ks[12], (N_A, 2, REC_BLOCKS, HEAD_DIM, HEAD_DIM), jnp.float32) * HEAD_DIM ** -0.5
    a_gate_b = 0.01 * nrm(ks[13], (N_A, 2, REC_W), jnp.float32)
    u = jax.random.uniform(ks[14], (N_A, REC_W), jnp.float32, minval=0.9, maxval=0.999)
    p = u ** (1.0 / LRU_C)
    a_lambda = jnp.log(p) - jnp.log1p(-p)
    b_w_in = nrm(ks[15], (N_B, d, SB_W + MEM_W), jnp.float32) * d ** -0.5
    kv_norm_g = 1.0 + 0.1 * nrm(ks[16], (d,), jnp.float32)
    w_kv_shared = nrm(ks[17], (d, 2 * SB_W), jnp.float32) * d ** -0.5
    return {"x": x, "mem": mem, "ffn_w_gate": ffn_w_gate, "ffn_w_up": ffn_w_up,
            "ffn_w_down": ffn_w_down, "norm_g": norm_g, "mem_norm_g": mem_norm_g,
            "w_mem_kv": w_mem_kv, "w_mix_out": w_mix_out, "a_w_in": a_w_in,
            "a_conv_w": a_conv_w, "a_conv_b": a_conv_b, "a_gate_w": a_gate_w,
            "a_gate_b": a_gate_b, "a_lambda": a_lambda, "b_w_in": b_w_in,
            "kv_norm_g": kv_norm_g, "w_kv_shared": w_kv_shared}


def reference(x, mem, ffn_w_gate, ffn_w_up, ffn_w_down, norm_g, mem_norm_g, w_mem_kv,
              w_mix_out, a_w_in, a_conv_w, a_conv_b, a_gate_w, a_gate_b, a_lambda,
              b_w_in, kv_norm_g, w_kv_shared):
    bsz, s, _ = x.shape
    k_sh = v_sh = None
    for layer in range(DEPTH):
        g = norm_g[layer]
        if layer == N_A:
            kv = (rms_norm(x, kv_norm_g) @ w_kv_shared).reshape(bsz, s, 2, SB_HEADS, HEAD_DIM)
            k_sh = kv[:, :, 0].transpose(0, 2, 1, 3)
            v_sh = kv[:, :, 1].transpose(0, 2, 1, 3)
        f = swiglu(rms_norm(x, g[0]), ffn_w_gate[layer, 0], ffn_w_up[layer, 0], ffn_w_down[layer, 0])
        x = x + 0.5 * rms_norm(f, g[1])
        hn = rms_norm(x, g[2])
        mem_n = rms_norm(mem, mem_norm_g[layer])
        if layer < N_A:
            proj = hn @ a_w_in[layer]
            x_rec = proj[..., :REC_W]
            x_gate = proj[..., REC_W:2 * REC_W]
            q_mem = proj[..., 2 * REC_W:]
            xc = causal_depthwise_conv(x_rec, a_conv_w[layer], a_conv_b[layer])
            h_rec = rg_lru(xc, a_gate_w[layer], a_gate_b[layer], a_lambda[layer])
            y_main = jax.nn.gelu(x_gate) * h_rec
        else:
            proj = hn @ b_w_in[layer - N_A]
            q_sb = proj[..., :SB_W].reshape(bsz, s, SB_HEADS, HEAD_DIM).transpose(0, 2, 1, 3)
            q_mem = proj[..., SB_W:]
            y_main = stick_breaking_attention(q_sb, k_sh, v_sh)
        y_mem = memory_attention(q_mem, mem_n, w_mem_kv[layer])
        mix = jnp.concatenate([y_main, y_mem], axis=-1) @ w_mix_out[layer]
        x = x + rms_norm(mix, g[3])
        f = swiglu(rms_norm(x, g[4]), ffn_w_gate[layer, 1], ffn_w_up[layer, 1], ffn_w_down[layer, 1])
        x = x + 0.5 * rms_norm(f, g[5])
    return x
```

```cpp
#include <hip/hip_runtime.h>
#include <hip/hip_cooperative_groups.h>
#include <cstdio>
#include <cstdint>
namespace cg = cooperative_groups;

typedef __bf16 mk_bf16x2_t __attribute__((ext_vector_type(2)));
typedef float mk_f32x2_t __attribute__((ext_vector_type(2)));
__device__ __forceinline__ unsigned pk2(float a, float b) { mk_f32x2_t v = {a, b}; mk_bf16x2_t r = __builtin_convertvector(v, mk_bf16x2_t); return __builtin_bit_cast(unsigned, r); }

namespace pg8 {
#define PG8_LAS __attribute__((address_space(3)))
typedef unsigned short bf16_t;
typedef short bf16x8 __attribute__((ext_vector_type(8)));
typedef float f32x4 __attribute__((ext_vector_type(4)));
typedef unsigned u32x4 __attribute__((ext_vector_type(4)));
constexpr int BM = 256, BK = 64, HALF = 128, HTB = HALF * BK * 2  , STAGE_BYTES = 8 * HTB, NXCD = 8, WGM = 8;

__host__ __device__ __forceinline__ int lds_byte(int r, int c) { const int st = (r >> 4) * 2 + (c >> 5), rr = r & 15, cc = c & 31, ob = rr * 64 + cc * 2; return st * 1024 + (ob ^ (((ob >> 9) & 1) << 5)); }
__host__ __device__ __forceinline__ void stage_rc(int b, int& R, int& C) { const int st = b / 1024, sb = b % 1024, swz = sb ^ (((sb >> 9) & 1) << 5); R = (st >> 1) * 16 + swz / 64; C = (st & 1) * 32 + (swz % 64) / 2; }
__host__ __device__ __forceinline__ int perm32(int rho) { const int n = rho >> 4, i = rho & 15; return 8 * (i >> 2) + 4 * n + (i & 3); }

struct Unit { int pm, pn; };
struct Gemm { const bf16_t* A; const bf16_t* Bt; int M, N, K; };

struct StaticOrder {
    int nM, nN, nwg, G, c;
    __host__ __device__ void init(int M, int N, int G_, int c_) { nM = M / BM; nN = N / BM; nwg = nM * nN; G = G_; c = c_; }
    __host__ __device__ bool next(int i, Unit& u) const {
        const long L = (long)i * G + c; if (L >= nwg) return false;
        int wgid = (int)L; { const int q = nwg / NXCD, r = nwg % NXCD, xcd = wgid % NXCD, off = wgid / NXCD; wgid = (xcd < r ? xcd * (q + 1) : r * (q + 1) + (xcd - r) * q) + off; }
        const int nig = WGM * nN, gid = wgid / nig, fm = gid * WGM, gsz = (nM - fm) < WGM ? (nM - fm) : WGM;
        u.pm = fm + ((wgid % nig) % gsz); u.pn = (wgid % nig) / gsz; return true;
    }
    __device__ __forceinline__ void a_ready(const Unit&) const {}
    __device__ __forceinline__ void done(const Unit&) const {}
};

struct RsOrder : StaticOrder {
    const float* rs; PG8_LAS unsigned char* rsl; mutable int k;
    __device__ __forceinline__ void a_ready(const Unit& u) const {
        if (rs) { if ((threadIdx.x >> 6) == 0) __builtin_amdgcn_global_load_lds((const unsigned*)(rs + 256 * u.pm + 4 * (threadIdx.x & 63)), (PG8_LAS unsigned*)(rsl + (k & 1) * 1024), 16, 0, 0); ++k; }
    }
};
struct EpiBf16S {
    static constexpr bool PERM = true, AFTER_DRAIN = false;
    bf16_t* O; int ldc; float scale; int scale_from_pn; const float* rs; int rs_mode; const PG8_LAS float* rsl;
    __device__ __forceinline__ void operator()(const f32x4 (&acc)[2][2][4][2], const Unit& u, int wr, int wc, int fr, int fq) const {
        const float s = (u.pn >= scale_from_pn) ? scale : 1.0f;
        int fr_ = fr, fq_ = fq; asm volatile("" : "+v"(fr_), "+v"(fq_));
        const int row0 = u.pm * BM + wr * 64 + fr_, col0 = u.pn * BM + wc * 32 + 8 * fq_;
        f32x4 c0[2], c1[2];
#pragma unroll
        for (int bj = 0; bj < 2; ++bj) { c0[bj] = (f32x4){s, s, s, s}; c1[bj] = c0[bj];
            if (rs_mode == 2) { c0[bj] = *(const f32x4*)(rs + col0 + bj * HALF) * s; c1[bj] = *(const f32x4*)(rs + col0 + bj * HALF + 4) * s; } }
#pragma unroll
        for (int ai = 0; ai < 2; ++ai)
#pragma unroll
            for (int m = 0; m < 4; ++m) { const int row = row0 + ai * HALF + m * 16; bf16_t* rowp = O + (size_t)row * ldc + col0;
                const float sr = (rs_mode == 1) ? rsl[ai * HALF + wr * 64 + m * 16 + fr_] : 1.0f;
#pragma unroll
                for (int bj = 0; bj < 2; ++bj) { const f32x4 v0 = acc[ai][bj][m][0] * (c0[bj] * sr), v1 = acc[ai][bj][m][1] * (c1[bj] * sr);
                    u32x4 w; w.x = pk2(v0[0], v0[1]); w.y = pk2(v0[2], v0[3]); w.z = pk2(v1[0], v1[1]); w.w = pk2(v1[2], v1[3]);
                    *(u32x4*)(rowp + bj * HALF) = w; } }
    }
};
struct EpiSwiGLU {
    static constexpr bool PERM = true, AFTER_DRAIN = false;
    bf16_t* O; int ldc; const PG8_LAS float* rsl;
    __device__ __forceinline__ void operator()(const f32x4 (&acc)[2][2][4][2], const Unit& u, int wr, int wc, int fr, int fq) const {
        int fr_ = fr, fq_ = fq; asm volatile("" : "+v"(fr_), "+v"(fq_));
        const int row0 = u.pm * BM + wr * 64 + fr_, col0 = u.pn * HALF + wc * 32 + 8 * fq_;
#pragma unroll
        for (int ai = 0; ai < 2; ++ai)
#pragma unroll
            for (int m = 0; m < 4; ++m) { const int row = row0 + ai * HALF + m * 16; bf16_t* rowp = O + (size_t)row * ldc + col0;
                const float sr = rsl[ai * HALF + wr * 64 + m * 16 + fr_];
                float h[8];
#pragma unroll
                for (int n = 0; n < 2; ++n)
#pragma unroll
                    for (int j = 0; j < 4; ++j) { const float g = acc[ai][0][m][n][j] * sr, up = acc[ai][1][m][n][j] * sr;
                        h[4 * n + j] = g * __builtin_amdgcn_rcpf(1.0f + __builtin_amdgcn_exp2f(-1.44269504f * g)) * up; }
                u32x4 w; w.x = pk2(h[0], h[1]); w.y = pk2(h[2], h[3]); w.z = pk2(h[4], h[5]); w.w = pk2(h[6], h[7]);
                *(u32x4*)rowp = w; }
    }
};

struct EpiU {
    static constexpr bool PERM = true, AFTER_DRAIN = false;
    bf16_t* O; int ldc; float scale; int scale_from_pn; int mode; const float* rs; int rs_mode; PG8_LAS unsigned char* rsl; mutable int k;
    __device__ __forceinline__ void operator()(const f32x4 (&acc)[2][2][4][2], const Unit& u, int wr, int wc, int fr, int fq) const {
        const PG8_LAS float* slot = (const PG8_LAS float*)(rsl + (k & 1) * 1024); if (rs_mode == 1) ++k;
        if (mode == 0) { EpiBf16S e{O, ldc, scale, scale_from_pn, rs, rs_mode, slot}; e(acc, u, wr, wc, fr, fq); }
        else { EpiSwiGLU e{O, ldc, slot}; e(acc, u, wr, wc, fr, fq); }
    }
};
template <class Epi, class Sched, bool ALIGN_EPI, bool SP2, int KC>
__device__ __forceinline__ void gemm_phase(PG8_LAS unsigned char* lds, const Gemm g, const Sched& S, const Epi& E) {
    const int tid = threadIdx.x, wid = __builtin_amdgcn_readfirstlane(tid >> 6), lane = tid & 63, wr = wid >> 2, wc = wid & 3, fr = lane & 15, fq = lane >> 4;
    constexpr int K = KC, nt = K / BK;
    unsigned voffA[2], voffB[2];
#pragma unroll
    for (int i = 0; i < 2; ++i) { int R, C; stage_rc(tid * 16 + i * 8192, R, C); const int Rb = Epi::PERM ? ((R & ~31) + perm32(R & 31)) : R;
        voffA[i] = (unsigned)(R * K + C) * 2u; voffB[i] = (unsigned)(Rb * K + C) * 2u; }
    const size_t kstep = (size_t)(BK * 2);
    const size_t hstep = (size_t)HALF * K * 2;
    const size_t tstep = 2 * hstep;
    const unsigned ldsw = (unsigned)wid * 1024u;
    const int aoff = lds_byte(wr * 64 + fr, fq * 8), boff = lds_byte(wc * 32 + fr, fq * 8);
#define PG8_SA(b, h) (((b) * 2 + (h)) * HTB)
#define PG8_SB(b, h) ((4 + (b) * 2 + (h)) * HTB)
#define PG8_STAGE(bufoff, gbase, voff) do { _Pragma("unroll") for (int _i = 0; _i < 2; ++_i) \
        __builtin_amdgcn_global_load_lds((const unsigned*)((const char*)(gbase) + (voff)[_i]), (PG8_LAS unsigned*)(lds + (bufoff) + ldsw + _i * 8192), 16, 0, 0); } while (0)
#define PG8_LDA(dst, b, h) do { _Pragma("unroll") for (int m = 0; m < 4; ++m) _Pragma("unroll") for (int k = 0; k < 2; ++k) dst[m][k] = *(const PG8_LAS bf16x8*)(lds + PG8_SA(b, h) + aoff + m * 2048 + k * 1024); } while (0)
#define PG8_LDB(dst, b, h) do { _Pragma("unroll") for (int n = 0; n < 2; ++n) _Pragma("unroll") for (int k = 0; k < 2; ++k) dst[n][k] = *(const PG8_LAS bf16x8*)(lds + PG8_SB(b, h) + boff + n * 2048 + k * 1024); } while (0)
#define PG8_MMA(ai, bj, At, Bt) do { __builtin_amdgcn_s_setprio(1); _Pragma("unroll") for (int m = 0; m < 4; ++m) _Pragma("unroll") for (int n = 0; n < 2; ++n) _Pragma("unroll") for (int k = 0; k < 2; ++k) \
        acc[ai][bj][m][n] = __builtin_amdgcn_mfma_f32_16x16x32_bf16(Bt[n][k], At[m][k], acc[ai][bj][m][n], 0, 0, 0); __builtin_amdgcn_s_setprio(0); } while (0)
#define PG8_WAIT_V(n) asm volatile("s_waitcnt vmcnt(" #n ")" ::: "memory")
#define PG8_WAIT_L(n) asm volatile("s_waitcnt lgkmcnt(" #n ")" ::: "memory")
#define PG8_BAR __builtin_amdgcn_s_barrier()
#define PG8_SCHED __builtin_amdgcn_sched_barrier(0)
    Unit cur, nxt; int ui = 0;
    if (!S.next(0, cur)) return;
    f32x4 acc[2][2][4][2];
#pragma unroll
    for (int a = 0; a < 2; ++a)
#pragma unroll
        for (int b = 0; b < 2; ++b)
#pragma unroll
            for (int m = 0; m < 4; ++m)
#pragma unroll
                for (int n = 0; n < 2; ++n) acc[a][b][m][n] = (f32x4){0.f, 0.f, 0.f, 0.f};
    bf16x8 At[4][2], B0[2][2], B1[2][2];
    const char* cA = (const char*)g.A + (size_t)cur.pm * tstep; const char* cB = (const char*)g.Bt + (size_t)cur.pn * tstep;
    S.a_ready(cur);
    if constexpr (SP2) {
        PG8_STAGE(PG8_SB(0, 0), cB, voffB); PG8_STAGE(PG8_SB(0, 1), cB + hstep, voffB); PG8_STAGE(PG8_SA(0, 0), cA, voffA); PG8_STAGE(PG8_SA(0, 1), cA + hstep, voffA);
        if (wr == 1) PG8_BAR;
        PG8_WAIT_V(2); PG8_BAR;
        PG8_STAGE(PG8_SB(1, 0), cB + kstep, voffB); PG8_STAGE(PG8_SA(1, 0), cA + kstep, voffA); PG8_STAGE(PG8_SB(1, 1), cB + hstep + kstep, voffB);
        PG8_WAIT_V(6); PG8_BAR;
    } else {
        PG8_STAGE(PG8_SB(0, 0), cB, voffB); PG8_STAGE(PG8_SA(0, 0), cA, voffA); PG8_STAGE(PG8_SB(0, 1), cB + hstep, voffB); PG8_STAGE(PG8_SA(0, 1), cA + hstep, voffA);
        if (wr == 1) PG8_BAR;
        PG8_WAIT_V(4); PG8_BAR;
        PG8_STAGE(PG8_SB(1, 0), cB + kstep, voffB); PG8_STAGE(PG8_SA(1, 0), cA + kstep, voffA); PG8_STAGE(PG8_SB(1, 1), cB + hstep + kstep, voffB);
        PG8_WAIT_V(6); PG8_BAR;
    }
    for (;;) {
        const bool has_next = S.next(ui + 1, nxt);
        const char* nA = has_next ? (const char*)g.A + (size_t)nxt.pm * tstep : cA; const char* nB = has_next ? (const char*)g.Bt + (size_t)nxt.pn * tstep : cB;
        for (int t = 0; t < nt; t += 2) {
            const bool last = (t == nt - 2);
            const char* a1 = cA + (size_t)(t + 1) * kstep;
            const char* a2 = last ? nA : cA + (size_t)(t + 2) * kstep; const char* b2 = last ? nB : cB + (size_t)(t + 2) * kstep;
            const char* a3 = a2 + kstep; const char* b3 = b2 + kstep;
            if (last && has_next) S.a_ready(nxt);
            if constexpr (SP2) {
            PG8_LDB(B0, 0, 0); PG8_LDB(B1, 0, 1); PG8_SCHED; PG8_LDA(At, 0, 0); PG8_STAGE(PG8_SA(1, 1), a1 + hstep, voffA);
            PG8_WAIT_V(8); PG8_WAIT_L(0); PG8_BAR; PG8_MMA(0, 0, At, B0); PG8_MMA(0, 1, At, B1); PG8_BAR; PG8_SCHED;
            PG8_LDA(At, 0, 1); PG8_STAGE(PG8_SB(0, 0), b2, voffB); PG8_STAGE(PG8_SB(0, 1), b2 + hstep, voffB); PG8_STAGE(PG8_SA(0, 0), a2, voffA);
            PG8_WAIT_V(8); PG8_WAIT_L(0); PG8_BAR; PG8_MMA(1, 0, At, B0); PG8_MMA(1, 1, At, B1); PG8_BAR; PG8_SCHED;
            PG8_LDB(B0, 1, 0); PG8_LDB(B1, 1, 1); PG8_SCHED; PG8_LDA(At, 1, 0); PG8_STAGE(PG8_SA(0, 1), a2 + hstep, voffA);
            PG8_WAIT_V(8); PG8_WAIT_L(0); PG8_BAR; PG8_MMA(0, 0, At, B0); PG8_MMA(0, 1, At, B1); PG8_BAR; PG8_SCHED;
            PG8_LDA(At, 1, 1); PG8_STAGE(PG8_SB(1, 0), b3, voffB); PG8_STAGE(PG8_SB(1, 1), b3 + hstep, voffB); PG8_STAGE(PG8_SA(1, 0), a3, voffA);
            PG8_WAIT_V(8); PG8_WAIT_L(0); PG8_BAR; PG8_MMA(1, 0, At, B0); PG8_MMA(1, 1, At, B1); PG8_BAR; PG8_SCHED;
            } else {
            PG8_LDB(B0, 0, 0); PG8_SCHED; PG8_LDA(At, 0, 0); PG8_STAGE(PG8_SA(1, 1), a1 + hstep, voffA);
            PG8_WAIT_L(8); PG8_BAR; PG8_WAIT_L(0); PG8_MMA(0, 0, At, B0); PG8_BAR; PG8_SCHED;
            PG8_LDB(B1, 0, 1); PG8_STAGE(PG8_SB(0, 0), b2, voffB);
            PG8_BAR; PG8_WAIT_L(0); PG8_MMA(0, 1, At, B1); PG8_BAR;
            PG8_LDA(At, 0, 1); PG8_STAGE(PG8_SA(0, 0), a2, voffA);
            PG8_BAR; PG8_WAIT_L(0); PG8_MMA(1, 0, At, B0); PG8_BAR; PG8_SCHED;
            PG8_STAGE(PG8_SB(0, 1), b2 + hstep, voffB);
            PG8_WAIT_V(6); PG8_BAR; PG8_MMA(1, 1, At, B1); PG8_BAR;
            PG8_LDB(B0, 1, 0); PG8_SCHED; PG8_LDA(At, 1, 0); PG8_STAGE(PG8_SA(0, 1), a2 + hstep, voffA);
            PG8_WAIT_L(8); PG8_BAR; PG8_WAIT_L(0); PG8_MMA(0, 0, At, B0); PG8_BAR; PG8_SCHED;
            PG8_LDB(B1, 1, 1); PG8_STAGE(PG8_SB(1, 0), b3, voffB);
            PG8_BAR; PG8_WAIT_L(0); PG8_MMA(0, 1, At, B1); PG8_BAR;
            PG8_LDA(At, 1, 1); PG8_STAGE(PG8_SA(1, 0), a3, voffA);
            PG8_BAR; PG8_WAIT_L(0); PG8_MMA(1, 0, At, B0); PG8_BAR; PG8_SCHED;
            PG8_STAGE(PG8_SB(1, 1), b3 + hstep, voffB);
            PG8_WAIT_V(6); PG8_BAR; PG8_MMA(1, 1, At, B1); PG8_BAR;
            }
        }
        if constexpr (ALIGN_EPI) { if (wr == 0) PG8_BAR; }
        if constexpr (!Epi::AFTER_DRAIN) { E(acc, cur, wr, wc, fr, fq); S.done(cur); }
        if (!has_next) break;
#pragma unroll
        for (int a = 0; a < 2; ++a)
#pragma unroll
            for (int b = 0; b < 2; ++b)
#pragma unroll
                for (int m = 0; m < 4; ++m)
#pragma unroll
                    for (int n = 0; n < 2; ++n) acc[a][b][m][n] = (f32x4){0.f, 0.f, 0.f, 0.f};
        cur = nxt; cA = nA; cB = nB; ++ui;
        if constexpr (ALIGN_EPI) { if (wr == 1) PG8_BAR; }
    }
    PG8_WAIT_V(0);
    if constexpr (!ALIGN_EPI) { if (wr == 0) PG8_BAR; }
    PG8_BAR;
    if constexpr (Epi::AFTER_DRAIN) { E.fused(acc, cur, wr, wc, fr, fq, lds, wid, lane); S.done(cur); }
#undef PG8_SA
#undef PG8_SB
#undef PG8_STAGE
#undef PG8_LDA
#undef PG8_LDB
#undef PG8_MMA
#undef PG8_WAIT_V
#undef PG8_WAIT_L
#undef PG8_BAR
#undef PG8_SCHED
}
}

#define LAS __attribute__((address_space(3)))
typedef unsigned short bf16;
typedef float f32x4 __attribute__((ext_vector_type(4)));
typedef float f32x16 __attribute__((ext_vector_type(16)));
typedef unsigned v4u __attribute__((ext_vector_type(4)));
typedef unsigned v2u __attribute__((ext_vector_type(2)));
typedef short bf16x8 __attribute__((ext_vector_type(8)));

constexpr int NB = 2, SEQ = 16384, M = NB * SEQ, D = 1024, FF = 2816, RW = 768, MW = 256, NMEM = 256, NH = 12, PROJ_LD = 2 * RW + MW;
constexpr int TC = 128, NCHUNK = SEQ / TC, NBLK = 12;
constexpr float EPS = 1e-6f, QSCALE = 0.18033688f  , LOG2E = 1.44269504f;
#ifndef DUP_MISC
#define DUP_MISC 1
#endif
#ifndef ROWS_R
#define ROWS_R 4
#endif
#ifndef DUP_PRO
#define DUP_PRO DUP_MISC
#endif
#ifndef DUP_SA
#define DUP_SA DUP_MISC
#endif
#ifndef DUP_SC
#define DUP_SC DUP_MISC
#endif
#ifndef DUP_MA
#define DUP_MA DUP_MISC
#endif
#ifndef DUP_SB
#define DUP_SB DUP_MISC
#endif
#ifndef DUP_SYNC
#define DUP_SYNC 1
#endif
#ifndef DUP_GEMM
#define DUP_GEMM 1
#endif
constexpr int NWAVES = 8, NTHR = 512;
constexpr int LDS_BYTES = 131072 + 1024 + 2048;

constexpr size_t MiB = 1u << 20;
constexpr size_t SZ_WGU = (size_t)2 * FF * D * 2, SZ_WD = (size_t)D * FF * 2;
constexpr size_t WS_WGU = 1 * MiB, WS_WD = WS_WGU + 4 * SZ_WGU, WS_WAIN = WS_WD + 4 * SZ_WD, WS_WBIN = WS_WAIN + (size_t)PROJ_LD * D * 2,
                 WS_WKV = WS_WBIN + (size_t)D * D * 2, WS_WMIX = WS_WKV + (size_t)2 * RW * D * 2, WS_Z = WS_WMIX + (size_t)2 * D * D * 2, WS_WEND = WS_Z + (size_t)2048 * D * 2;
static_assert(WS_WEND <= 88 * MiB, "weights region");
constexpr size_t WS_XN = 88 * MiB;
constexpr size_t WS_Y = 152 * MiB;
constexpr size_t WS_H = 216 * MiB;
constexpr size_t WS_KV = 392 * MiB;
constexpr size_t WS_CZ = 488 * MiB;
constexpr size_t WS_AGG = 496 * MiB;
constexpr size_t WS_GWT = 500 * MiB;
constexpr size_t WS_RS = 504 * MiB;
constexpr size_t WS_END = 512 * MiB;

__device__ __forceinline__ float bflo(unsigned w) { return __uint_as_float(w << 16); }
__device__ __forceinline__ float bfhi(unsigned w) { return __uint_as_float(w & 0xffff0000u); }
__device__ __forceinline__ float bf2f(bf16 v) { return __uint_as_float(((unsigned)v) << 16); }
__device__ __forceinline__ bf16 f2bf(float f) { return (bf16)(pk2(f, 0.f) & 0xffffu); }
__device__ __forceinline__ float wave_sum(float v) {
#pragma unroll
    for (int o = 1; o < 64; o <<= 1) v += __shfl_xor(v, o);
    return v;
}
#define LDS_WAIT() asm volatile("s_waitcnt lgkmcnt(0)" ::: "memory")
#define MFMA32(a, b, c) __builtin_amdgcn_mfma_f32_32x32x16_bf16((a), (b), (c), 0, 0, 0)

__device__ __forceinline__ void tr_item(const float* W, int K, int N, bf16* WT, int mode, int row_off, LAS float* scr, int item, int lane, const float* gk) {
    const int nblk = N / 32, kb = item / nblk, nb = item % nblk, k0 = 64 * kb, n0 = 32 * nb;
#pragma unroll
    for (int i = 0; i < 8; ++i) { const int kk = 8 * i + (lane >> 3); const float gsc = gk ? gk[k0 + kk] : 1.0f;
        const f32x4 v = *(const f32x4*)(W + (size_t)(k0 + kk) * N + n0 + 4 * (lane & 7)) * gsc;
        LAS float* d = scr + kk * 33 + 4 * (lane & 7); d[0] = v.x; d[1] = v.y; d[2] = v.z; d[3] = v.w; }
    LDS_WAIT(); asm volatile("" ::: "memory");
    const int rb = (mode == 0) ? (row_off + n0) : (256 * (n0 >> 7) + (n0 & 127) + (mode == 2 ? 128 : 0));
    const int c = lane & 7;
#pragma unroll
    for (int j = 0; j < 4; ++j) { const int n = (lane >> 3) + 8 * j; const LAS float* s = scr + (8 * c) * 33 + n;
        v4u o; o.x = pk2(s[0 * 33], s[1 * 33]); o.y = pk2(s[2 * 33], s[3 * 33]); o.z = pk2(s[4 * 33], s[5 * 33]); o.w = pk2(s[6 * 33], s[7 * 33]);
        *(v4u*)(WT + (size_t)(rb + n) * K + k0 + 8 * c) = o; }
    LDS_WAIT(); asm volatile("" ::: "memory");
}

template <int R, bool XIB, bool XOB>
__device__ __forceinline__ void row_jobs(const void* xin, const bf16* F, const float* gf, float coef, void* xout, const float* g1, bf16* N1, const float* g2, bf16* N2, int m0, int ms, int lane, float* rsout = nullptr) {
    f32x4 v[R][4];
    if (XIB) {
        v2u xw[R][4];
#pragma unroll
        for (int k = 0; k < R; ++k)
#pragma unroll
            for (int j = 0; j < 4; ++j) xw[k][j] = *(const v2u*)((const bf16*)xin + (size_t)(m0 + k * ms) * D + 4 * lane + 256 * j);
#pragma unroll
        for (int k = 0; k < R; ++k)
#pragma unroll
            for (int j = 0; j < 4; ++j) v[k][j] = (f32x4){bflo(xw[k][j].x), bfhi(xw[k][j].x), bflo(xw[k][j].y), bfhi(xw[k][j].y)};
    } else {
#pragma unroll
        for (int k = 0; k < R; ++k)
#pragma unroll
            for (int j = 0; j < 4; ++j) v[k][j] = *(const f32x4*)((const float*)xin + (size_t)(m0 + k * ms) * D + 4 * lane + 256 * j);
    }
    if (F) {
        v2u fw[R][4];
#pragma unroll
        for (int k = 0; k < R; ++k)
#pragma unroll
            for (int j = 0; j < 4; ++j) fw[k][j] = *(const v2u*)(F + (size_t)(m0 + k * ms) * D + 4 * lane + 256 * j);
        f32x4 gfv[4];
#pragma unroll
        for (int j = 0; j < 4; ++j) gfv[j] = *(const f32x4*)(gf + 4 * lane + 256 * j);
#pragma unroll
        for (int k = 0; k < R; ++k) {
            f32x4 f[4]; float ss = 0.f;
#pragma unroll
            for (int j = 0; j < 4; ++j) { f[j] = (f32x4){bflo(fw[k][j].x), bfhi(fw[k][j].x), bflo(fw[k][j].y), bfhi(fw[k][j].y)};
                ss += (f[j].x * f[j].x + f[j].y * f[j].y) + (f[j].z * f[j].z + f[j].w * f[j].w); }
            ss = wave_sum(ss);
            const float rf = rsqrtf(ss * (1.0f / D) + EPS) * coef;
#pragma unroll
            for (int j = 0; j < 4; ++j) v[k][j] = v[k][j] + f[j] * gfv[j] * rf;
        }
    }
    if (xout) {
#pragma unroll
        for (int k = 0; k < R; ++k)
#pragma unroll
            for (int j = 0; j < 4; ++j) {
                if (XOB) { v2u w; w.x = pk2(v[k][j].x, v[k][j].y); w.y = pk2(v[k][j].z, v[k][j].w); *(v2u*)((bf16*)xout + (size_t)(m0 + k * ms) * D + 4 * lane + 256 * j) = w; }
                else *(f32x4*)((float*)xout + (size_t)(m0 + k * ms) * D + 4 * lane + 256 * j) = v[k][j]; }
    }
    if (N1 || N2 || rsout) {
        float r[R];
#pragma unroll
        for (int k = 0; k < R; ++k) { float s2 = 0.f;
#pragma unroll
            for (int j = 0; j < 4; ++j) s2 += (v[k][j].x * v[k][j].x + v[k][j].y * v[k][j].y) + (v[k][j].z * v[k][j].z + v[k][j].w * v[k][j].w);
            r[k] = rsqrtf(wave_sum(s2) * (1.0f / D) + EPS); if (rsout && lane == 0) rsout[m0 + k * ms] = r[k]; }
        if (N1) {
#pragma unroll
            for (int j = 0; j < 4; ++j) { const f32x4 g = *(const f32x4*)(g1 + 4 * lane + 256 * j);
#pragma unroll
                for (int k = 0; k < R; ++k) { const f32x4 o = v[k][j] * g * r[k]; v2u w; w.x = pk2(o.x, o.y); w.y = pk2(o.z, o.w); *(v2u*)(N1 + (size_t)(m0 + k * ms) * D + 4 * lane + 256 * j) = w; } }
        }
        if (N2) {
#pragma unroll
            for (int j = 0; j < 4; ++j) { const f32x4 g = *(const f32x4*)(g2 + 4 * lane + 256 * j);
#pragma unroll
                for (int k = 0; k < R; ++k) { const f32x4 o = v[k][j] * g * r[k]; v2u w; w.x = pk2(o.x, o.y); w.y = pk2(o.z, o.w); *(v2u*)(N2 + (size_t)(m0 + k * ms) * D + 4 * lane + 256 * j) = w; } }
        }
    }
}
__device__ __forceinline__ void row_job(const float* xr, const bf16* fr, const float* gf, float coef, float* xo, const float* g1, bf16* n1, const float* g2, bf16* n2, int lane) {
    row_jobs<1, false, false>(xr, fr, gf, coef, xo, g1, n1, g2, n2, 0, 0, lane);
}

__device__ __forceinline__ int kappa(int rho) { return 16 * ((rho >> 2) & 1) + 4 * (rho >> 3) + (rho & 3); }
__device__ __forceinline__ bf16x8 pack8(const f32x16& w, int s) {
    v4u p; p.x = pk2(w[8 * s + 0], w[8 * s + 1]); p.y = pk2(w[8 * s + 2], w[8 * s + 3]); p.z = pk2(w[8 * s + 4], w[8 * s + 5]); p.w = pk2(w[8 * s + 6], w[8 * s + 7]);
    return __builtin_bit_cast(bf16x8, p);
}
__device__ __forceinline__ void store_o(bf16* yrow, const f32x16& o0, const f32x16& o1, float sc, int hh) {
#pragma unroll
    for (int g = 0; g < 4; ++g) {
        v2u a; a.x = pk2(o0[4 * g] * sc, o0[4 * g + 1] * sc); a.y = pk2(o0[4 * g + 2] * sc, o0[4 * g + 3] * sc); *(v2u*)(yrow + 8 * g + 4 * hh) = a;
        v2u b; b.x = pk2(o1[4 * g] * sc, o1[4 * g + 1] * sc); b.y = pk2(o1[4 * g + 2] * sc, o1[4 * g + 3] * sc); *(v2u*)(yrow + 32 + 8 * g + 4 * hh) = b;
    }
}

__device__ __forceinline__ void mem_attn_unit(const bf16* Q, int ldq, int qcol, const bf16* CZ, int l, bf16* Y, int unit, int lane) {
    const int tile = unit >> 2, h = unit & 3, r = lane & 31, hh = lane >> 5;
    const int tok0 = tile * 32, b = tok0 / SEQ;
    bf16x8 qf[4];
#pragma unroll
    for (int s = 0; s < 4; ++s) qf[s] = *(const bf16x8*)(Q + (size_t)(tok0 + r) * ldq + qcol + h * 64 + 16 * s + 8 * hh);
    const bf16* Kb = CZ + (size_t)(l * 512 + b * 256 + kappa(r)) * 2048 + 1024 + l * 512 + h * 64 + 8 * hh;
    const bf16* Vb = CZ + (size_t)(1024 + l * 512 + 256 + h * 64 + r) * 2048 + l * 512 + b * 256 + 16 * hh;
    float mrun = -1e30f, lsum = 0.f;
    f32x16 o0, o1;
#pragma unroll
    for (int i = 0; i < 16; ++i) { o0[i] = 0.f; o1[i] = 0.f; }
    bf16x8 kf[4], vf[2][2];
#pragma unroll
    for (int s = 0; s < 4; ++s) kf[s] = *(const bf16x8*)(Kb + 16 * s);
#pragma unroll
    for (int dt = 0; dt < 2; ++dt)
#pragma unroll
        for (int s = 0; s < 2; ++s) vf[dt][s] = *(const bf16x8*)(Vb + (size_t)dt * 32 * 2048 + 8 * s);
    for (int kt = 0; kt < 8; ++kt) {
        bf16x8 kn[4], vn[2][2];
        const int ktn = kt < 7 ? kt + 1 : 7;
#pragma unroll
        for (int s = 0; s < 4; ++s) kn[s] = *(const bf16x8*)(Kb + (size_t)ktn * 32 * 2048 + 16 * s);
#pragma unroll
        for (int dt = 0; dt < 2; ++dt)
#pragma unroll
            for (int s = 0; s < 2; ++s) vn[dt][s] = *(const bf16x8*)(Vb + (size_t)dt * 32 * 2048 + ktn * 32 + 8 * s);
        f32x16 st;
#pragma unroll
        for (int i = 0; i < 16; ++i) st[i] = 0.f;
#pragma unroll
        for (int s = 0; s < 4; ++s) st = MFMA32(kf[s], qf[s], st);
        float mx = st[0];
#pragma unroll
        for (int i = 1; i < 16; ++i) mx = fmaxf(mx, st[i]);
        mx = fmaxf(mx, __shfl_xor(mx, 32));
        const float mnew = fmaxf(mrun, mx), alpha = __builtin_amdgcn_exp2f(mrun - mnew);
        mrun = mnew;
        float ps = 0.f;
#pragma unroll
        for (int i = 0; i < 16; ++i) { st[i] = __builtin_amdgcn_exp2f(st[i] - mnew); ps += st[i]; }
        lsum = lsum * alpha + ps;
#pragma unroll
        for (int i = 0; i < 16; ++i) { o0[i] *= alpha; o1[i] *= alpha; }
        const bf16x8 p0 = pack8(st, 0), p1 = pack8(st, 1);
        o0 = MFMA32(vf[0][0], p0, o0); o0 = MFMA32(vf[0][1], p1, o0);
        o1 = MFMA32(vf[1][0], p0, o1); o1 = MFMA32(vf[1][1], p1, o1);
#pragma unroll
        for (int s = 0; s < 4; ++s) kf[s] = kn[s];
        vf[0][0] = vn[0][0]; vf[0][1] = vn[0][1]; vf[1][0] = vn[1][0]; vf[1][1] = vn[1][1];
    }
    const float tot = lsum + __shfl_xor(lsum, 32);
    store_o(Y + (size_t)(tok0 + r) * D + RW + h * 64, o0, o1, 1.0f / tot, hh);
}

__device__ __forceinline__ void sb_attn_unit(const bf16* Q, const bf16* KB, const bf16* VT, bf16* Y, int unit, int lane) {
    const int qt = unit & 511, bh = unit >> 9, h = bh % NH, b = bh / NH, r = lane & 31, hh = lane >> 5;
    const size_t tok0 = (size_t)b * SEQ + qt * 32;
    bf16x8 qf[4];
#pragma unroll
    for (int s = 0; s < 4; ++s) qf[s] = *(const bf16x8*)(Q + (tok0 + r) * D + h * 64 + 16 * s + 8 * hh);
    const bf16* Kb = KB + ((size_t)b * SEQ + kappa(r)) * RW + h * 64 + 8 * hh;
    const bf16* Vb = VT + (size_t)(h * 64 + r) * M + (size_t)b * SEQ + 16 * hh;
    float rest = 0.f;
    f32x16 o0, o1;
#pragma unroll
    for (int i = 0; i < 16; ++i) { o0[i] = 0.f; o1[i] = 0.f; }
    bf16x8 kf[4], vf[2][2];
#pragma unroll
    for (int s = 0; s < 4; ++s) kf[s] = *(const bf16x8*)(Kb + (size_t)qt * 32 * RW + 16 * s);
#pragma unroll
    for (int dt = 0; dt < 2; ++dt)
#pragma unroll
        for (int s = 0; s < 2; ++s) vf[dt][s] = *(const bf16x8*)(Vb + (size_t)dt * 32 * M + qt * 32 + 8 * s);
    for (int kt = qt; kt >= 0; --kt) {
        bf16x8 kn[4], vn[2][2];
        const int ktn = kt > 0 ? kt - 1 : 0;
#pragma unroll
        for (int s = 0; s < 4; ++s) kn[s] = *(const bf16x8*)(Kb + (size_t)ktn * 32 * RW + 16 * s);
#pragma unroll
        for (int dt = 0; dt < 2; ++dt)
#pragma unroll
            for (int s = 0; s < 2; ++s) vn[dt][s] = *(const bf16x8*)(Vb + (size_t)dt * 32 * M + ktn * 32 + 8 * s);
        f32x16 z;
#pragma unroll
        for (int i = 0; i < 16; ++i) z[i] = 0.f;
#pragma unroll
        for (int s = 0; s < 4; ++s) z = MFMA32(kf[s], qf[s], z);
        float t[16];
#pragma unroll
        for (int i = 0; i < 16; ++i) t[i] = __builtin_amdgcn_exp2f(fminf(z[i], 30.0f));
        if (kt == qt) {
#pragma unroll
            for (int i = 0; i < 16; ++i) t[i] = (16 * hh + i < r) ? t[i] : 0.f;
        }
        float lg[4]; f32x16 w;
#pragma unroll
        for (int g = 0; g < 4; ++g) {
            const float u0 = 1.f + t[4 * g], u1 = 1.f + t[4 * g + 1], u2 = 1.f + t[4 * g + 2], u3 = 1.f + t[4 * g + 3];
            const float p1 = u0, p2 = p1 * u1, p3 = p2 * u2, G = p3 * u3;
            lg[g] = __builtin_amdgcn_logf(G);
            w[4 * g] = t[4 * g]; w[4 * g + 1] = t[4 * g + 1] * p1; w[4 * g + 2] = t[4 * g + 2] * p2; w[4 * g + 3] = t[4 * g + 3] * p3;
        }
        const float LT = (lg[0] + lg[1]) + (lg[2] + lg[3]);
        const float OT = __shfl_xor(LT, 32);
        float sg = rest - (hh == 0 ? OT : 0.f);
#pragma unroll
        for (int g = 3; g >= 0; --g) { sg -= lg[g]; const float e = __builtin_amdgcn_exp2f(sg);
            w[4 * g] *= e; w[4 * g + 1] *= e; w[4 * g + 2] *= e; w[4 * g + 3] *= e; }
        rest = rest - LT - OT;
        const bf16x8 p0 = pack8(w, 0), p1 = pack8(w, 1);
        o0 = MFMA32(vf[0][0], p0, o0); o0 = MFMA32(vf[0][1], p1, o0);
        o1 = MFMA32(vf[1][0], p0, o1); o1 = MFMA32(vf[1][1], p1, o1);
        if (__all(rest < -32.0f)) break;
#pragma unroll
        for (int s = 0; s < 4; ++s) kf[s] = kn[s];
        vf[0][0] = vn[0][0]; vf[0][1] = vn[0][1]; vf[1][0] = vn[1][0]; vf[1][1] = vn[1][1];
    }
    store_o(Y + (tok0 + r) * D + h * 64, o0, o1, 1.0f, hh);
}

__device__ __forceinline__ void scan_a_unit(LAS unsigned char* lds, const bf16* PROJ, const float* conv_w, const float* conv_b, const bf16* GWT, const float* gate_b,
                                            const float* lam, bf16* HL, bf16* PP, float* AGG, int unit, int tid) {
    const int n = unit % NBLK, c = (unit / NBLK) % NCHUNK, b = unit / (NBLK * NCHUNK);
    LAS float* xr = (LAS float*)lds;
    LAS float* xc = (LAS float*)(lds + 34816);
    LAS bf16* xcb = (LAS bf16*)(lds + 34816 + 32768);
    LAS bf16* wt = xcb + 128 * 72;
    LAS float* part = (LAS float*)(wt + 128 * 72);
    const int t0 = c * TC;
    const size_t tokbase = (size_t)b * SEQ + t0;
    { unsigned xw[9]; v4u gw_[2];
#pragma unroll
      for (int it = 0; it < 9; ++it) { const int idx = tid + NTHR * it, row = idx >> 5, cp = idx & 31, t = t0 - 3 + row; xw[it] = 0u;
        if (idx < 131 * 32 && t >= 0) xw[it] = *(const unsigned*)(PROJ + ((size_t)b * SEQ + t) * PROJ_LD + n * 64 + 2 * cp); }
#pragma unroll
      for (int it = 0; it < 2; ++it) { const int idx = tid + NTHR * it, row = idx >> 3, ck = idx & 7; gw_[it] = *(const v4u*)(GWT + (size_t)n * 8192 + row * 64 + 8 * ck); }
#pragma unroll
      for (int it = 0; it < 9; ++it) { const int idx = tid + NTHR * it, row = idx >> 5, cp = idx & 31;
        if (idx < 131 * 32) { xr[row * 64 + 2 * cp] = bflo(xw[it]); xr[row * 64 + 2 * cp + 1] = bfhi(xw[it]); } }
#pragma unroll
      for (int it = 0; it < 2; ++it) { const int idx = tid + NTHR * it, row = idx >> 3, ck = idx & 7; *(LAS v4u*)(wt + row * 72 + 8 * ck) = gw_[it]; } }
    __syncthreads();
    { const int ch = tid & 63, sub = tid >> 6, col = n * 64 + ch;
      const float w0 = conv_w[col], w1 = conv_w[RW + col], w2 = conv_w[2 * RW + col], w3 = conv_w[3 * RW + col], cb = conv_b[col];
#pragma unroll
      for (int i = 0; i < 16; ++i) { const int t = sub * 16 + i;
        const float v = cb + w0 * xr[t * 64 + ch] + w1 * xr[(t + 1) * 64 + ch] + w2 * xr[(t + 2) * 64 + ch] + w3 * xr[(t + 3) * 64 + ch];
        xc[t * 64 + ch] = v; xcb[t * 72 + ch] = f2bf(v); } }
    __syncthreads();
    const int wv = tid >> 6, lane = tid & 63, c32 = lane & 31, hh = lane >> 5, tg = wv >> 1, ch = 32 * (wv & 1) + c32, sub = 2 * tg + hh, col = n * 64 + ch;
    f32x16 ar, ai;
    { const float br = gate_b[col], bi = gate_b[RW + col];
#pragma unroll
      for (int i = 0; i < 16; ++i) { ar[i] = br; ai[i] = bi; } }
#pragma unroll
    for (int s = 0; s < 4; ++s) {
        const bf16x8 af = *(const LAS bf16x8*)(xcb + (32 * tg + kappa(c32)) * 72 + 16 * s + 8 * hh);
        const bf16x8 br_ = *(const LAS bf16x8*)(wt + ch * 72 + 16 * s + 8 * hh), bi_ = *(const LAS bf16x8*)(wt + (64 + ch) * 72 + 16 * s + 8 * hh);
        ar = MFMA32(af, br_, ar); ai = MFMA32(af, bi_, ai);
    }
    const float c8 = -8.0f * LOG2E * log1pf(expf(-lam[col]));
    float hl[16], pp[16]; float hcur = 0.f, pcur = 1.f;
#pragma unroll
    for (int i = 0; i < 16; ++i) {
        const float rg = __builtin_amdgcn_rcpf(1.0f + __builtin_amdgcn_exp2f(-LOG2E * ar[i])), ig = __builtin_amdgcn_rcpf(1.0f + __builtin_amdgcn_exp2f(-LOG2E * ai[i]));
        const float a = __builtin_amdgcn_exp2f(c8 * rg), mult = __builtin_amdgcn_sqrtf(fmaxf(1.0f - a * a, 0.0f));
        hcur = a * hcur + mult * ig * xc[(sub * 16 + i) * 64 + ch]; pcur *= a; hl[i] = hcur; pp[i] = pcur; }
    part[(sub * 64 + ch) * 2] = pcur; part[(sub * 64 + ch) * 2 + 1] = hcur;
    __syncthreads();
    float hc = 0.f, pc = 1.f;
    for (int s = 0; s < sub; ++s) { const float ps = part[(s * 64 + ch) * 2], hs = part[(s * 64 + ch) * 2 + 1]; hc = ps * hc + hs; pc *= ps; }
#pragma unroll
    for (int i = 0; i < 16; ++i) { hl[i] += pp[i] * hc; pp[i] *= pc; }
#pragma unroll
    for (int i = 0; i < 16; ++i) { const size_t o = (tokbase + sub * 16 + i) * RW + col; HL[o] = f2bf(hl[i]); PP[o] = f2bf(pp[i]); }
    if (sub == 7) { float* ag = AGG + ((size_t)(b * NCHUNK + c) * RW + col) * 2; ag[0] = pp[15]; ag[1] = hl[15]; }
    __syncthreads();
}
__device__ __forceinline__ void scan_c_unit(LAS unsigned char* lds, const bf16* PROJ, const bf16* HL, const bf16* PP, const float* AGG, bf16* Y, int unit, int tid) {
    const int n = unit % NBLK, c = (unit / NBLK) % NCHUNK, b = unit / (NBLK * NCHUNK);
    LAS float* part = (LAS float*)lds;
    LAS float* carryL = part + 1024;
    const int ch = tid & 63, sub = tid >> 6, col = n * 64 + ch;
    const size_t tokbase = (size_t)b * SEQ + c * TC;
    { mk_f32x2_t ag[16];
#pragma unroll
      for (int k = 0; k < 16; ++k) ag[k] = *(const mk_f32x2_t*)(AGG + ((size_t)(b * NCHUNK + sub * 16 + k) * RW + col) * 2);
      float pq = 1.f, hq = 0.f;
#pragma unroll
      for (int k = 0; k < 16; ++k) { const bool use = (sub * 16 + k) < c; const float pa = use ? ag[k].x : 1.f, ha = use ? ag[k].y : 0.f; hq = pa * hq + ha; pq *= pa; }
      part[(sub * 64 + ch) * 2] = pq; part[(sub * 64 + ch) * 2 + 1] = hq; }
    __syncthreads();
    if (tid < 64) { float carry = 0.f;
#pragma unroll
        for (int s = 0; s < 8; ++s) carry = part[(s * 64 + tid) * 2] * carry + part[(s * 64 + tid) * 2 + 1];
        carryL[tid] = carry; }
    __syncthreads();
#pragma unroll
    for (int it = 0; it < 2; ++it) { const int item = tid + NTHR * it, tok = item >> 3, ck = item & 7;
        const size_t row = tokbase + tok;
        const v4u hv = *(const v4u*)(HL + row * RW + n * 64 + 8 * ck), pv = *(const v4u*)(PP + row * RW + n * 64 + 8 * ck), gv = *(const v4u*)(PROJ + row * PROJ_LD + RW + n * 64 + 8 * ck);
        float y[8];
#pragma unroll
        for (int q = 0; q < 4; ++q) {
#pragma unroll
            for (int hf = 0; hf < 2; ++hf) {
                const float hl_ = hf ? bfhi(hv[q]) : bflo(hv[q]), pp_ = hf ? bfhi(pv[q]) : bflo(pv[q]), xg = hf ? bfhi(gv[q]) : bflo(gv[q]);
                const float hfull = hl_ + pp_ * carryL[8 * ck + 2 * q + hf];
                const float uu = 0.7978845608f * (xg + 0.044715f * xg * xg * xg);
                y[2 * q + hf] = xg * __builtin_amdgcn_rcpf(1.0f + __builtin_amdgcn_exp2f(-2.0f * LOG2E * uu)) * hfull; } }
        v4u o; o.x = pk2(y[0], y[1]); o.y = pk2(y[2], y[3]); o.z = pk2(y[4], y[5]); o.w = pk2(y[6], y[7]);
        *(v4u*)(Y + row * D + n * 64 + 8 * ck) = o; }
    __syncthreads();
}

#define XB_TMO      128
#define XB_XCNT(j)  (256  + 64 * (j))
#define XB_XSUB(j)  (1280 + 64 * (j))
#define XB_XGEN(j)  (2304 + 64 * (j))
#define XB_TOP      3328
#define XB_TOPGEN   3392
#define XCD_BAR_WORDS 3456
#define XB_SPIN_CAP (1u << 18)

__device__ __forceinline__ unsigned xb_ld(unsigned* p)              { return __hip_atomic_load(p, __ATOMIC_RELAXED, __HIP_MEMORY_SCOPE_AGENT); }
__device__ __forceinline__ unsigned xb_add(unsigned* p, unsigned v) { return __hip_atomic_fetch_add(p, v, __ATOMIC_RELAXED, __HIP_MEMORY_SCOPE_AGENT); }
__device__ __forceinline__ unsigned xb_xcc_id() { return (unsigned)__builtin_amdgcn_s_getreg((3 << 11) | 20) & 0xFu; }
#define XB_SPIN(cond, bar) do { unsigned _sp = 0; while (cond) { __builtin_amdgcn_s_sleep(1); \
    if ((++_sp & 255u) == 0u) { if (xb_ld(&(bar)[XB_TMO])) break; if (_sp > XB_SPIN_CAP) { atomicAdd(&(bar)[XB_TMO], 1u); break; } } } } while (0)

struct XcdBarrier {
    unsigned* bar; unsigned x;
    volatile LAS unsigned* st;
};

__device__ __forceinline__ XcdBarrier xcd_barrier_post(unsigned* bar, volatile LAS unsigned* st) {
    XcdBarrier b; b.bar = bar; b.x = xb_xcc_id(); b.st = st;
    if (threadIdx.x == 0) (void)xb_add(&bar[XB_XCNT(b.x)], 1u);
    return b;
}
__device__ __forceinline__ void xcd_barrier_complete(unsigned* bar, unsigned x, unsigned& nloc, unsigned& nx) {
    const unsigned G = gridDim.x * gridDim.y * gridDim.z;
    unsigned sum, cnt, mine, sp = 0u;
    for (;;) {
        sum = 0u; cnt = 0u; mine = 0u;
#pragma unroll
        for (unsigned j = 0; j < 16; ++j) { const unsigned c = xb_ld(&bar[XB_XCNT(j)]); sum += c; cnt += (c > 0u) ? 1u : 0u; mine = (j == x) ? c : mine; }
        if (sum == G) break;
        __builtin_amdgcn_s_sleep(1);
        if ((++sp & 255u) == 0u) { if (xb_ld(&bar[XB_TMO])) break; if (sp > XB_SPIN_CAP) { atomicAdd(&bar[XB_TMO], 1u); break; } }
    }
    nloc = mine > 0u ? mine : 1u; nx = cnt > 0u ? cnt : 1u;
}

__device__ __forceinline__ void xcd_barrier(const XcdBarrier& b) {
    asm volatile("s_waitcnt vmcnt(0)" ::: "memory");
    __syncthreads();
    if (threadIdx.x == 0) {
        unsigned* bar = b.bar;
        __builtin_amdgcn_s_waitcnt(0);
        unsigned nloc = b.st[0], nx = b.st[1];
        if (nloc == 0u) { xcd_barrier_complete(bar, b.x, nloc, nx); b.st[0] = nloc; b.st[1] = nx; }
        const unsigned old = xb_add(&bar[XB_XSUB(b.x)], 1u);
        const unsigned gen = old / nloc;
        if (old + 1u == (gen + 1u) * nloc) {
            __builtin_amdgcn_fence(__ATOMIC_RELEASE, "agent");
            asm volatile("s_waitcnt vmcnt(0)" ::: "memory");
            const unsigned og = xb_add(&bar[XB_TOP], 1u);
            const unsigned tg = og / nx;
            if (og + 1u == (tg + 1u) * nx) xb_add(&bar[XB_TOPGEN], 1u);
            else XB_SPIN(xb_ld(&bar[XB_TOPGEN]) == tg, bar);
            __builtin_amdgcn_fence(__ATOMIC_ACQUIRE, "agent");
            xb_add(&bar[XB_XGEN(b.x)], 1u);
            asm volatile("s_waitcnt vmcnt(0)" ::: "memory");
        } else {
            XB_SPIN(xb_ld(&bar[XB_XGEN(b.x)]) == gen, bar);
            __builtin_amdgcn_fence(__ATOMIC_ACQUIRE, "agent");
            asm volatile("s_waitcnt vmcnt(0)" ::: "memory");
        }
    }
    __syncthreads();
}


#define KARG_ ((const unsigned char __attribute__((address_space(4)))*)__builtin_amdgcn_kernarg_segment_ptr())
#define IN_(i) (*(const float* const __attribute__((address_space(4)))*)(KARG_ + 8 * (i)))
#define OUT_ (*(float* const __attribute__((address_space(4)))*)(KARG_ + 144))
#define WSP_ (*(unsigned char* const __attribute__((address_space(4)))*)(KARG_ + 152))
struct Args { const float* in[18]; float* out; unsigned char* ws; int cg_sync; int pad; };
__global__ void __launch_bounds__(NTHR, 2) yoco_fwd(Args args) {
    extern __shared__ __attribute__((aligned(16))) unsigned char lds_raw[];
    LAS unsigned char* lds = (LAS unsigned char*)lds_raw;
    cg::grid_group grid = cg::this_grid();
    if (threadIdx.x < 256) ((LAS unsigned*)(lds + 131072))[threadIdx.x] = 0u;
    __syncthreads();
    const XcdBarrier xbar = xcd_barrier_post((unsigned*)WSP_, (volatile LAS unsigned*)(lds + 131072));
    const int tid = threadIdx.x, lane = tid & 63, wave = __builtin_amdgcn_readfirstlane(tid >> 6);
    const int G = gridDim.x, bx = blockIdx.x;
    const int gw = bx * NWAVES + wave, ngw = G * NWAVES;
#define WSB(off) ((bf16*)(WSP_ + (off)))
#define GEMM(KC, Aptr, Bptr, Mm, Nn, cid, Optr, ldo, scl, from, md, rsp, rsm) do { pg8::Gemm g_{(const pg8::bf16_t*)(Aptr), (const pg8::bf16_t*)(Bptr), (Mm), (Nn), (KC)}; pg8::RsOrder S_; S_.init((Mm), (Nn), G, (cid)); S_.rs = ((rsm) == 1) ? (const float*)(rsp) : (const float*)nullptr; S_.rsl = lds + 132096; S_.k = 0; \
        pg8::EpiU E_{(pg8::bf16_t*)(Optr), (ldo), (scl), (from), (md), (rsp), (rsm), lds + 132096, 0}; pg8::gemm_phase<pg8::EpiU, pg8::RsOrder, true, true, (KC)>(lds, g_, S_, E_); if (DUP_GEMM > 1) { asm volatile("" ::: "memory"); pg8::gemm_phase<pg8::EpiU, pg8::RsOrder, true, true, (KC)>(lds, g_, S_, E_); } } while (0)
#define ROWS(XIB, XOB, xin, xout, gf, coef, rso) do { for (int m = gw; m < M; m += ROWS_R * ngw) row_jobs<ROWS_R, XIB, XOB>((xin), WSB(WS_XN), (gf), (coef), (xout), (const float*)nullptr, (bf16*)nullptr, (const float*)nullptr, (bf16*)nullptr, m, ngw, lane, (rso)); } while (0)
#define RS_ ((float*)(WSP_ + WS_RS))
#define XB_ ((bf16*)OUT_ + (size_t)M * D)
#define XB2_ WSB(WS_Y)
#define GSYNC() do { xcd_barrier(xbar); if (DUP_SYNC > 1) xcd_barrier(xbar); } while (0)
#define DUPX(n, ...) do { __VA_ARGS__; if ((n) > 1) { asm volatile("" ::: "memory"); __VA_ARGS__; } if ((n) > 2) { asm volatile("" ::: "memory"); __VA_ARGS__; } } while (0)
#define NORMG(l, k) (IN_(5) + ((l) * 6 + (k)) * D)
    constexpr int NOSC = 1 << 30;
    for (int rep_ = 0; rep_ < DUP_PRO; ++rep_) {
        LAS float* scr = (LAS float*)(lds + wave * 16384);
        constexpr int I_FF = 16 * 88, I_DN = 44 * 32, I_AIN = 16 * 56, I_BIN = 16 * 32, I_KV = 16 * 48, I_MIX = 16 * 32, I_MKV = 16 * 16;
        constexpr int NITEMS = 12 * I_FF + I_AIN + I_BIN + I_KV + 2 * I_MIX + 2 * I_MKV;
        static_assert(I_FF == I_DN, "item counts");
        for (int it = gw; it < NITEMS; it += ngw) {
            int r = it; const float* W; int K = D, N = D, mode = 0; bf16* WT; const float* gk = nullptr;
            if (r < 4 * I_FF) { const int sub = r / I_FF; W = IN_(2) + (size_t)sub * D * FF; N = FF; WT = WSB(WS_WGU) + (size_t)sub * 2 * FF * D; mode = 1; r %= I_FF; gk = NORMG(sub >> 1, (sub & 1) ? 4 : 0); }
            else if ((r -= 4 * I_FF) < 4 * I_FF) { const int sub = r / I_FF; W = IN_(3) + (size_t)sub * D * FF; N = FF; WT = WSB(WS_WGU) + (size_t)sub * 2 * FF * D; mode = 2; r %= I_FF; gk = NORMG(sub >> 1, (sub & 1) ? 4 : 0); }
            else if ((r -= 4 * I_FF) < 4 * I_DN) { const int sub = r / I_DN; W = IN_(4) + (size_t)sub * FF * D; K = FF; WT = WSB(WS_WD) + (size_t)sub * D * FF; r %= I_DN; }
            else if ((r -= 4 * I_DN) < I_AIN) { W = IN_(9); N = PROJ_LD; WT = WSB(WS_WAIN); gk = NORMG(0, 2); }
            else if ((r -= I_AIN) < I_BIN) { W = IN_(15); WT = WSB(WS_WBIN); gk = NORMG(1, 2); }
            else if ((r -= I_BIN) < I_KV) { W = IN_(17); N = 2 * RW; WT = WSB(WS_WKV); gk = IN_(16); }
            else if ((r -= I_KV) < 2 * I_MIX) { const int sub = r / I_MIX; W = IN_(8) + (size_t)sub * D * D; WT = WSB(WS_WMIX) + (size_t)sub * D * D; r %= I_MIX; }
            else { r -= 2 * I_MIX; const int sub = r / I_MKV; W = IN_(7) + (size_t)sub * D * 512; N = 512; WT = WSB(WS_Z) + (size_t)(1024 + sub * 512) * D; r %= I_MKV; }
            tr_item(W, K, N, WT, mode, 0, scr, r, lane, gk);
        }
        for (int idx = gw * 64 + lane; idx < 12 * 128 * 64; idx += ngw * 64) { const int in_ = idx & 63, row = (idx >> 6) & 127, nn = idx >> 13, g_ = row >> 6, out_ = row & 63;
            WSB(WS_GWT)[idx] = f2bf(IN_(12)[((size_t)(g_ * NBLK + nn) * 64 + in_) * 64 + out_]); }
        for (int j = gw; j < 1024; j += ngw) { const int l = j >> 9, rr = j & 511; row_job(IN_(1) + (size_t)rr * D, nullptr, nullptr, 0.f, nullptr, IN_(6) + l * D, WSB(WS_Z) + (size_t)j * D, nullptr, nullptr, lane); }
        for (int m = gw; m < M; m += ROWS_R * ngw) row_jobs<ROWS_R, false, true>(IN_(0), (const bf16*)nullptr, (const float*)nullptr, 0.f, XB_, (const float*)nullptr, (bf16*)nullptr, (const float*)nullptr, (bf16*)nullptr, m, ngw, lane, RS_);
    }
    if (*(const int __attribute__((address_space(4)))*)(KARG_ + 160)) grid.sync();
    GSYNC();
    GEMM(D, XB_, WSB(WS_WGU), M, 2 * FF, bx, WSB(WS_H), FF, 1.0f, NOSC, 1, RS_, 1);
    GSYNC();
    GEMM(FF, WSB(WS_H), WSB(WS_WD), M, D, bx, WSB(WS_XN), D, 1.0f, NOSC, 0, (const float*)nullptr, 0);
    GSYNC();
    ROWS(false, true, IN_(0), XB_, NORMG(0, 1), 0.5f, RS_);
    GSYNC();
    GEMM(D, XB_, WSB(WS_WAIN), M, PROJ_LD, bx, WSB(WS_H), PROJ_LD, QSCALE, 6, 0, RS_, 1);
    GEMM(D, WSB(WS_Z), WSB(WS_Z), 2048, 2048, (bx + 64) % G, WSB(WS_CZ), 2048, 1.0f, NOSC, 0, (const float*)nullptr, 0);
    GSYNC();
    for (int u = bx; u < NB * NCHUNK * NBLK; u += G) scan_a_unit(lds, WSB(WS_H), IN_(10), IN_(11), WSB(WS_GWT), IN_(13), IN_(14), WSB(WS_KV), WSB(WS_KV) + (size_t)M * RW, (float*)(WSP_ + WS_AGG), u, tid);
    if (DUP_SA > 1) { asm volatile("" ::: "memory"); for (int u = bx; u < NB * NCHUNK * NBLK; u += G) scan_a_unit(lds, WSB(WS_H), IN_(10), IN_(11), WSB(WS_GWT), IN_(13), IN_(14), WSB(WS_KV), WSB(WS_KV) + (size_t)M * RW, (float*)(WSP_ + WS_AGG), u, tid); }
    if (DUP_SA > 2) { asm volatile("" ::: "memory"); for (int u = bx; u < NB * NCHUNK * NBLK; u += G) scan_a_unit(lds, WSB(WS_H), IN_(10), IN_(11), WSB(WS_GWT), IN_(13), IN_(14), WSB(WS_KV), WSB(WS_KV) + (size_t)M * RW, (float*)(WSP_ + WS_AGG), u, tid); }
    GSYNC();
    DUPX(DUP_SC, for (int u = bx; u < NB * NCHUNK * NBLK; u += G) scan_c_unit(lds, WSB(WS_H), WSB(WS_KV), WSB(WS_KV) + (size_t)M * RW, (const float*)(WSP_ + WS_AGG), WSB(WS_Y), u, tid));
    DUPX(DUP_MA, for (int u = gw; u < (M / 32) * 4; u += ngw) mem_attn_unit(WSB(WS_H), PROJ_LD, 2 * RW, WSB(WS_CZ), 0, WSB(WS_Y), u, lane));
    GSYNC();
    GEMM(D, WSB(WS_Y), WSB(WS_WMIX), M, D, bx, WSB(WS_XN), D, 1.0f, NOSC, 0, (const float*)nullptr, 0);
    GSYNC();
    ROWS(true, true, XB_, XB_, NORMG(0, 3), 1.0f, RS_);
    GSYNC();
    GEMM(D, XB_, WSB(WS_WGU) + (size_t)1 * 2 * FF * D, M, 2 * FF, bx, WSB(WS_H), FF, 1.0f, NOSC, 1, RS_, 1);
    GSYNC();
    GEMM(FF, WSB(WS_H), WSB(WS_WD) + (size_t)1 * D * FF, M, D, bx, WSB(WS_XN), D, 1.0f, NOSC, 0, (const float*)nullptr, 0);
    GSYNC();
    ROWS(true, true, XB_, XB_, NORMG(0, 5), 0.5f, RS_);
    GSYNC();
    GEMM(D, XB_, WSB(WS_WKV), M, RW, bx, WSB(WS_KV), RW, 1.0f, NOSC, 0, RS_, 1);
    GEMM(D, WSB(WS_WKV) + (size_t)RW * D, XB_, RW, M, (bx + G / 2) % G, WSB(WS_KV) + (size_t)M * RW, M, 1.0f, NOSC, 0, RS_, 2);
    GEMM(D, XB_, WSB(WS_WGU) + (size_t)2 * 2 * FF * D, M, 2 * FF, bx, WSB(WS_H), FF, 1.0f, NOSC, 1, RS_, 1);
    GSYNC();
    GEMM(FF, WSB(WS_H), WSB(WS_WD) + (size_t)2 * D * FF, M, D, bx, WSB(WS_XN), D, 1.0f, NOSC, 0, (const float*)nullptr, 0);
    GSYNC();
    ROWS(true, true, XB_, XB_, NORMG(1, 1), 0.5f, RS_);
    GSYNC();
    GEMM(D, XB_, WSB(WS_WBIN), M, D, bx, WSB(WS_H), D, QSCALE, 0, 0, RS_, 1);
    GSYNC();
    DUPX(DUP_SB, for (int u = gw; u < NB * NH * 512; u += ngw) sb_attn_unit(WSB(WS_H), WSB(WS_KV), WSB(WS_KV) + (size_t)M * RW, WSB(WS_Y), u, lane));
    DUPX(DUP_MA, for (int u = gw; u < (M / 32) * 4; u += ngw) mem_attn_unit(WSB(WS_H), D, RW, WSB(WS_CZ), 1, WSB(WS_Y), u, lane));
    GSYNC();
    GEMM(D, WSB(WS_Y), WSB(WS_WMIX) + (size_t)D * D, M, D, bx, WSB(WS_XN), D, 1.0f, NOSC, 0, (const float*)nullptr, 0);
    GSYNC();
    ROWS(true, true, XB_, XB2_, NORMG(1, 3), 1.0f, RS_);
    GSYNC();
    GEMM(D, XB2_, WSB(WS_WGU) + (size_t)3 * 2 * FF * D, M, 2 * FF, bx, WSB(WS_H), FF, 1.0f, NOSC, 1, RS_, 1);
    GSYNC();
    GEMM(FF, WSB(WS_H), WSB(WS_WD) + (size_t)3 * D * FF, M, D, bx, WSB(WS_XN), D, 1.0f, NOSC, 0, (const float*)nullptr, 0);
    GSYNC();
    ROWS(true, false, XB2_, OUT_, NORMG(1, 5), 0.5f, (float*)nullptr);
}

#undef IN_
#undef XB_
#undef RS_
#undef XB2_
#undef OUT_
#undef WSP_
extern "C" void kernel_launch(void* const* d_in, const int* in_sizes, int n_in, void* d_out, int out_size, void* d_ws, size_t ws_size, hipStream_t stream) {
    static int grid = 0;
    if (grid == 0) {
        if (n_in != 18 || out_size != M * D || ws_size < WS_END) { fprintf(stderr, "kernel_launch: unexpected shapes (n_in %d out %d ws %zu)\n", n_in, out_size, ws_size); grid = -1; return; }
        int dev = 0, cus = 0, per_cu = 0;
        hipGetDevice(&dev); hipDeviceGetAttribute(&cus, hipDeviceAttributeMultiprocessorCount, dev);
        if (hipFuncSetAttribute((const void*)yoco_fwd, hipFuncAttributeMaxDynamicSharedMemorySize, LDS_BYTES) != hipSuccess) { fprintf(stderr, "kernel_launch: hipFuncSetAttribute failed\n"); grid = -1; return; }
        if (hipOccupancyMaxActiveBlocksPerMultiprocessor(&per_cu, (const void*)yoco_fwd, NTHR, LDS_BYTES) != hipSuccess || per_cu < 1) { fprintf(stderr, "kernel_launch: occupancy query says %d\n", per_cu); per_cu = 1; }
        (void)hipGetLastError();
        grid = cus;
    }
    if (grid < 0) return;
    if (hipMemsetAsync(d_ws, 0, XCD_BAR_WORDS * 4, stream) != hipSuccess) { fprintf(stderr, "kernel_launch: memset of the barrier words failed\n"); return; }
    Args a{};
    for (int i = 0; i < 18; ++i) a.in[i] = (const float*)d_in[i];
    a.out = (float*)d_out; a.ws = (unsigned char*)d_ws;
    void* kargs[] = {&a};
    hipError_t e = hipLaunchCooperativeKernel((const void*)yoco_fwd, dim3(grid), dim3(NTHR), kargs, LDS_BYTES, stream);
    if (e != hipSuccess) fprintf(stderr, "kernel_launch: cooperative launch failed: %s (grid %d)\n", hipGetErrorString(e), grid);
}
```

```cpp
#include <hip/hip_runtime.h>
#include <hip/hip_cooperative_groups.h>
#include <cstdio>
#include <cstdint>
namespace cg = cooperative_groups;

typedef __bf16 mk_bf16x2_t __attribute__((ext_vector_type(2)));
typedef float mk_f32x2_t __attribute__((ext_vector_type(2)));
__device__ __forceinline__ unsigned pk2(float a, float b) { mk_f32x2_t v = {a, b}; mk_bf16x2_t r = __builtin_convertvector(v, mk_bf16x2_t); return __builtin_bit_cast(unsigned, r); }

namespace pg8 {
#define PG8_LAS __attribute__((address_space(3)))
typedef unsigned short bf16_t;
typedef short bf16x8 __attribute__((ext_vector_type(8)));
typedef float f32x4 __attribute__((ext_vector_type(4)));
typedef unsigned u32x4 __attribute__((ext_vector_type(4)));
constexpr int BM = 256, BK = 64, HALF = 128, HTB = HALF * BK * 2  , STAGE_BYTES = 8 * HTB, NXCD = 8, WGM = 8;

__host__ __device__ __forceinline__ int lds_byte(int r, int c) { const int st = (r >> 4) * 2 + (c >> 5), rr = r & 15, cc = c & 31, ob = rr * 64 + cc * 2; return st * 1024 + (ob ^ (((ob >> 9) & 1) << 5)); }
__host__ __device__ __forceinline__ void stage_rc(int b, int& R, int& C) { const int st = b / 1024, sb = b % 1024, swz = sb ^ (((sb >> 9) & 1) << 5); R = (st >> 1) * 16 + swz / 64; C = (st & 1) * 32 + (swz % 64) / 2; }
__host__ __device__ __forceinline__ int perm32(int rho) { const int n = rho >> 4, i = rho & 15; return 8 * (i >> 2) + 4 * n + (i & 3); }

struct Unit { int pm, pn; };
struct Gemm { const bf16_t* A; const bf16_t* Bt; int M, N, K; };

struct StaticOrder {
    int nM, nN, nwg, G, c;
    __host__ __device__ void init(int M, int N, int G_, int c_) { nM = M / BM; nN = N / BM; nwg = nM * nN; G = G_; c = c_; }
    __host__ __device__ bool next(int i, Unit& u) const {
        const long L = (long)i * G + c; if (L >= nwg) return false;
        int wgid = (int)L; { const int q = nwg / NXCD, r = nwg % NXCD, xcd = wgid % NXCD, off = wgid / NXCD; wgid = (xcd < r ? xcd * (q + 1) : r * (q + 1) + (xcd - r) * q) + off; }
        const int nig = WGM * nN, gid = wgid / nig, fm = gid * WGM, gsz = (nM - fm) < WGM ? (nM - fm) : WGM;
        u.pm = fm + ((wgid % nig) % gsz); u.pn = (wgid % nig) / gsz; return true;
    }
    __device__ __forceinline__ void a_ready(const Unit&) const {}
    __device__ __forceinline__ void done(const Unit&) const {}
};

struct EpiBf16S {
    static constexpr bool PERM = true, AFTER_DRAIN = false;
    bf16_t* O; int ldc; float scale; int scale_from_pn; const float* rs; int rs_mode;
    __device__ __forceinline__ void operator()(const f32x4 (&acc)[2][2][4][2], const Unit& u, int wr, int wc, int fr, int fq) const {
        const float s = (u.pn >= scale_from_pn) ? scale : 1.0f;
        int fr_ = fr, fq_ = fq; asm volatile("" : "+v"(fr_), "+v"(fq_));
        const int row0 = u.pm * BM + wr * 64 + fr_, col0 = u.pn * BM + wc * 32 + 8 * fq_;
        f32x4 c0[2], c1[2];
#pragma unroll
        for (int bj = 0; bj < 2; ++bj) { c0[bj] = (f32x4){s, s, s, s}; c1[bj] = c0[bj];
            if (rs_mode == 2) { c0[bj] = *(const f32x4*)(rs + col0 + bj * HALF) * s; c1[bj] = *(const f32x4*)(rs + col0 + bj * HALF + 4) * s; } }
#pragma unroll
        for (int ai = 0; ai < 2; ++ai)
#pragma unroll
            for (int m = 0; m < 4; ++m) { const int row = row0 + ai * HALF + m * 16; bf16_t* rowp = O + (size_t)row * ldc + col0;
                const float sr = (rs_mode == 1) ? rs[row] : 1.0f;
#pragma unroll
                for (int bj = 0; bj < 2; ++bj) { const f32x4 v0 = acc[ai][bj][m][0] * (c0[bj] * sr), v1 = acc[ai][bj][m][1] * (c1[bj] * sr);
                    u32x4 w; w.x = pk2(v0[0], v0[1]); w.y = pk2(v0[2], v0[3]); w.z = pk2(v1[0], v1[1]); w.w = pk2(v1[2], v1[3]);
                    *(u32x4*)(rowp + bj * HALF) = w; } }
    }
};
struct EpiSwiGLU {
    static constexpr bool PERM = true, AFTER_DRAIN = false;
    bf16_t* O; int ldc; const float* rs;
    __device__ __forceinline__ void operator()(const f32x4 (&acc)[2][2][4][2], const Unit& u, int wr, int wc, int fr, int fq) const {
        int fr_ = fr, fq_ = fq; asm volatile("" : "+v"(fr_), "+v"(fq_));
        const int row0 = u.pm * BM + wr * 64 + fr_, col0 = u.pn * HALF + wc * 32 + 8 * fq_;
#pragma unroll
        for (int ai = 0; ai < 2; ++ai)
#pragma unroll
            for (int m = 0; m < 4; ++m) { const int row = row0 + ai * HALF + m * 16; bf16_t* rowp = O + (size_t)row * ldc + col0;
                const float sr = rs[row];
                float h[8];
#pragma unroll
                for (int n = 0; n < 2; ++n)
#pragma unroll
                    for (int j = 0; j < 4; ++j) { const float g = acc[ai][0][m][n][j] * sr, up = acc[ai][1][m][n][j] * sr;
                        h[4 * n + j] = g * __builtin_amdgcn_rcpf(1.0f + __builtin_amdgcn_exp2f(-1.44269504f * g)) * up; }
                u32x4 w; w.x = pk2(h[0], h[1]); w.y = pk2(h[2], h[3]); w.z = pk2(h[4], h[5]); w.w = pk2(h[6], h[7]);
                *(u32x4*)rowp = w; }
    }
};

struct EpiU {
    static constexpr bool PERM = true, AFTER_DRAIN = false;
    bf16_t* O; int ldc; float scale; int scale_from_pn; int mode; const float* rs; int rs_mode;
    __device__ __forceinline__ void operator()(const f32x4 (&acc)[2][2][4][2], const Unit& u, int wr, int wc, int fr, int fq) const {
        if (mode == 0) { EpiBf16S e{O, ldc, scale, scale_from_pn, rs, rs_mode}; e(acc, u, wr, wc, fr, fq); }
        else { EpiSwiGLU e{O, ldc, rs}; e(acc, u, wr, wc, fr, fq); }
    }
};
template <class Epi, class Sched, bool ALIGN_EPI, bool SP2, int KC>
__device__ __forceinline__ void gemm_phase(PG8_LAS unsigned char* lds, const Gemm g, const Sched& S, const Epi& E) {
    const int tid = threadIdx.x, wid = __builtin_amdgcn_readfirstlane(tid >> 6), lane = tid & 63, wr = wid >> 2, wc = wid & 3, fr = lane & 15, fq = lane >> 4;
    constexpr int K = KC, nt = K / BK;
    unsigned voffA[2], voffB[2];
#pragma unroll
    for (int i = 0; i < 2; ++i) { int R, C; stage_rc(tid * 16 + i * 8192, R, C); const int Rb = Epi::PERM ? ((R & ~31) + perm32(R & 31)) : R;
        voffA[i] = (unsigned)(R * K + C) * 2u; voffB[i] = (unsigned)(Rb * K + C) * 2u; }
    const size_t kstep = (size_t)(BK * 2);
    const size_t hstep = (size_t)HALF * K * 2;
    const size_t tstep = 2 * hstep;
    const unsigned ldsw = (unsigned)wid * 1024u;
    const int aoff = lds_byte(wr * 64 + fr, fq * 8), boff = lds_byte(wc * 32 + fr, fq * 8);
#define PG8_SA(b, h) (((b) * 2 + (h)) * HTB)
#define PG8_SB(b, h) ((4 + (b) * 2 + (h)) * HTB)
#define PG8_STAGE(bufoff, gbase, voff) do { _Pragma("unroll") for (int _i = 0; _i < 2; ++_i) \
        __builtin_amdgcn_global_load_lds((const unsigned*)((const char*)(gbase) + (voff)[_i]), (PG8_LAS unsigned*)(lds + (bufoff) + ldsw + _i * 8192), 16, 0, 0); } while (0)
#define PG8_LDA(dst, b, h) do { _Pragma("unroll") for (int m = 0; m < 4; ++m) _Pragma("unroll") for (int k = 0; k < 2; ++k) dst[m][k] = *(const PG8_LAS bf16x8*)(lds + PG8_SA(b, h) + aoff + m * 2048 + k * 1024); } while (0)
#define PG8_LDB(dst, b, h) do { _Pragma("unroll") for (int n = 0; n < 2; ++n) _Pragma("unroll") for (int k = 0; k < 2; ++k) dst[n][k] = *(const PG8_LAS bf16x8*)(lds + PG8_SB(b, h) + boff + n * 2048 + k * 1024); } while (0)
#define PG8_MMA(ai, bj, At, Bt) do { __builtin_amdgcn_s_setprio(1); _Pragma("unroll") for (int m = 0; m < 4; ++m) _Pragma("unroll") for (int n = 0; n < 2; ++n) _Pragma("unroll") for (int k = 0; k < 2; ++k) \
        acc[ai][bj][m][n] = __builtin_amdgcn_mfma_f32_16x16x32_bf16(Bt[n][k], At[m][k], acc[ai][bj][m][n], 0, 0, 0); __builtin_amdgcn_s_setprio(0); } while (0)
#define PG8_WAIT_V(n) asm volatile("s_waitcnt vmcnt(" #n ")" ::: "memory")
#define PG8_WAIT_L(n) asm volatile("s_waitcnt lgkmcnt(" #n ")" ::: "memory")
#define PG8_BAR __builtin_amdgcn_s_barrier()
#define PG8_SCHED __builtin_amdgcn_sched_barrier(0)
    Unit cur, nxt; int ui = 0;
    if (!S.next(0, cur)) return;
    f32x4 acc[2][2][4][2];
#pragma unroll
    for (int a = 0; a < 2; ++a)
#pragma unroll
        for (int b = 0; b < 2; ++b)
#pragma unroll
            for (int m = 0; m < 4; ++m)
#pragma unroll
                for (int n = 0; n < 2; ++n) acc[a][b][m][n] = (f32x4){0.f, 0.f, 0.f, 0.f};
    bf16x8 At[4][2], B0[2][2], B1[2][2];
    const char* cA = (const char*)g.A + (size_t)cur.pm * tstep; const char* cB = (const char*)g.Bt + (size_t)cur.pn * tstep;
    S.a_ready(cur);
    if constexpr (SP2) {
        PG8_STAGE(PG8_SB(0, 0), cB, voffB); PG8_STAGE(PG8_SB(0, 1), cB + hstep, voffB); PG8_STAGE(PG8_SA(0, 0), cA, voffA); PG8_STAGE(PG8_SA(0, 1), cA + hstep, voffA);
        if (wr == 1) PG8_BAR;
        PG8_WAIT_V(2); PG8_BAR;
        PG8_STAGE(PG8_SB(1, 0), cB + kstep, voffB); PG8_STAGE(PG8_SA(1, 0), cA + kstep, voffA); PG8_STAGE(PG8_SB(1, 1), cB + hstep + kstep, voffB);
        PG8_WAIT_V(6); PG8_BAR;
    } else {
        PG8_STAGE(PG8_SB(0, 0), cB, voffB); PG8_STAGE(PG8_SA(0, 0), cA, voffA); PG8_STAGE(PG8_SB(0, 1), cB + hstep, voffB); PG8_STAGE(PG8_SA(0, 1), cA + hstep, voffA);
        if (wr == 1) PG8_BAR;
        PG8_WAIT_V(4); PG8_BAR;
        PG8_STAGE(PG8_SB(1, 0), cB + kstep, voffB); PG8_STAGE(PG8_SA(1, 0), cA + kstep, voffA); PG8_STAGE(PG8_SB(1, 1), cB + hstep + kstep, voffB);
        PG8_WAIT_V(6); PG8_BAR;
    }
    for (;;) {
        const bool has_next = S.next(ui + 1, nxt);
        const char* nA = has_next ? (const char*)g.A + (size_t)nxt.pm * tstep : cA; const char* nB = has_next ? (const char*)g.Bt + (size_t)nxt.pn * tstep : cB;
        for (int t = 0; t < nt; t += 2) {
            const bool last = (t == nt - 2);
            const char* a1 = cA + (size_t)(t + 1) * kstep;
            const char* a2 = last ? nA : cA + (size_t)(t + 2) * kstep; const char* b2 = last ? nB : cB + (size_t)(t + 2) * kstep;
            const char* a3 = a2 + kstep; const char* b3 = b2 + kstep;
            if (last && has_next) S.a_ready(nxt);
            if constexpr (SP2) {
            PG8_LDB(B0, 0, 0); PG8_LDB(B1, 0, 1); PG8_SCHED; PG8_LDA(At, 0, 0); PG8_STAGE(PG8_SA(1, 1), a1 + hstep, voffA);
            PG8_WAIT_V(8); PG8_WAIT_L(0); PG8_BAR; PG8_MMA(0, 0, At, B0); PG8_MMA(0, 1, At, B1); PG8_BAR; PG8_SCHED;
            PG8_LDA(At, 0, 1); PG8_STAGE(PG8_SB(0, 0), b2, voffB); PG8_STAGE(PG8_SB(0, 1), b2 + hstep, voffB); PG8_STAGE(PG8_SA(0, 0), a2, voffA);
            PG8_WAIT_V(8); PG8_WAIT_L(0); PG8_BAR; PG8_MMA(1, 0, At, B0); PG8_MMA(1, 1, At, B1); PG8_BAR; PG8_SCHED;
            PG8_LDB(B0, 1, 0); PG8_LDB(B1, 1, 1); PG8_SCHED; PG8_LDA(At, 1, 0); PG8_STAGE(PG8_SA(0, 1), a2 + hstep, voffA);
            PG8_WAIT_V(8); PG8_WAIT_L(0); PG8_BAR; PG8_MMA(0, 0, At, B0); PG8_MMA(0, 1, At, B1); PG8_BAR; PG8_SCHED;
            PG8_LDA(At, 1, 1); PG8_STAGE(PG8_SB(1, 0), b3, voffB); PG8_STAGE(PG8_SB(1, 1), b3 + hstep, voffB); PG8_STAGE(PG8_SA(1, 0), a3, voffA);
            PG8_WAIT_V(8); PG8_WAIT_L(0); PG8_BAR; PG8_MMA(1, 0, At, B0); PG8_MMA(1, 1, At, B1); PG8_BAR; PG8_SCHED;
            } else {
            PG8_LDB(B0, 0, 0); PG8_SCHED; PG8_LDA(At, 0, 0); PG8_STAGE(PG8_SA(1, 1), a1 + hstep, voffA);
            PG8_WAIT_L(8); PG8_BAR; PG8_WAIT_L(0); PG8_MMA(0, 0, At, B0); PG8_BAR; PG8_SCHED;
            PG8_LDB(B1, 0, 1); PG8_STAGE(PG8_SB(0, 0), b2, voffB);
            PG8_BAR; PG8_WAIT_L(0); PG8_MMA(0, 1, At, B1); PG8_BAR;
            PG8_LDA(At, 0, 1); PG8_STAGE(PG8_SA(0, 0), a2, voffA);
            PG8_BAR; PG8_WAIT_L(0); PG8_MMA(1, 0, At, B0); PG8_BAR; PG8_SCHED;
            PG8_STAGE(PG8_SB(0, 1), b2 + hstep, voffB);
            PG8_WAIT_V(6); PG8_BAR; PG8_MMA(1, 1, At, B1); PG8_BAR;
            PG8_LDB(B0, 1, 0); PG8_SCHED; PG8_LDA(At, 1, 0); PG8_STAGE(PG8_SA(0, 1), a2 + hstep, voffA);
            PG8_WAIT_L(8); PG8_BAR; PG8_WAIT_L(0); PG8_MMA(0, 0, At, B0); PG8_BAR; PG8_SCHED;
            PG8_LDB(B1, 1, 1); PG8_STAGE(PG8_SB(1, 0), b3, voffB);
            PG8_BAR; PG8_WAIT_L(0); PG8_MMA(0, 1, At, B1); PG8_BAR;
            PG8_LDA(At, 1, 1); PG8_STAGE(PG8_SA(1, 0), a3, voffA);
            PG8_BAR; PG8_WAIT_L(0); PG8_MMA(1, 0, At, B0); PG8_BAR; PG8_SCHED;
            PG8_STAGE(PG8_SB(1, 1), b3 + hstep, voffB);
            PG8_WAIT_V(6); PG8_BAR; PG8_MMA(1, 1, At, B1); PG8_BAR;
            }
        }
        if constexpr (ALIGN_EPI) { if (wr == 0) PG8_BAR; }
        if constexpr (!Epi::AFTER_DRAIN) { E(acc, cur, wr, wc, fr, fq); S.done(cur); }
        if (!has_next) break;
#pragma unroll
        for (int a = 0; a < 2; ++a)
#pragma unroll
            for (int b = 0; b < 2; ++b)
#pragma unroll
                for (int m = 0; m < 4; ++m)
#pragma unroll
                    for (int n = 0; n < 2; ++n) acc[a][b][m][n] = (f32x4){0.f, 0.f, 0.f, 0.f};
        cur = nxt; cA = nA; cB = nB; ++ui;
        if constexpr (ALIGN_EPI) { if (wr == 1) PG8_BAR; }
    }
    PG8_WAIT_V(0);
    if constexpr (!ALIGN_EPI) { if (wr == 0) PG8_BAR; }
    PG8_BAR;
    if constexpr (Epi::AFTER_DRAIN) { E.fused(acc, cur, wr, wc, fr, fq, lds, wid, lane); S.done(cur); }
#undef PG8_SA
#undef PG8_SB
#undef PG8_STAGE
#undef PG8_LDA
#undef PG8_LDB
#undef PG8_MMA
#undef PG8_WAIT_V
#undef PG8_WAIT_L
#undef PG8_BAR
#undef PG8_SCHED
}
}

#define LAS __attribute__((address_space(3)))
typedef unsigned short bf16;
typedef float f32x4 __attribute__((ext_vector_type(4)));
typedef float f32x16 __attribute__((ext_vector_type(16)));
typedef unsigned v4u __attribute__((ext_vector_type(4)));
typedef unsigned v2u __attribute__((ext_vector_type(2)));
typedef short bf16x8 __attribute__((ext_vector_type(8)));

constexpr int NB = 2, SEQ = 16384, M = NB * SEQ, D = 1024, FF = 2816, RW = 768, MW = 256, NMEM = 256, NH = 12, PROJ_LD = 2 * RW + MW;
constexpr int TC = 128, NCHUNK = SEQ / TC, NBLK = 12;
constexpr float EPS = 1e-6f, QSCALE = 0.18033688f  , LOG2E = 1.44269504f;
#ifndef DUP_MISC
#define DUP_MISC 1
#endif
#ifndef ROWS_R
#define ROWS_R 4
#endif
#ifndef DUP_PRO
#define DUP_PRO DUP_MISC
#endif
#ifndef DUP_SA
#define DUP_SA DUP_MISC
#endif
#ifndef DUP_SC
#define DUP_SC DUP_MISC
#endif
#ifndef DUP_MA
#define DUP_MA DUP_MISC
#endif
#ifndef DUP_SB
#define DUP_SB DUP_MISC
#endif
#ifndef DUP_SYNC
#define DUP_SYNC 1
#endif
#ifndef DUP_GEMM
#define DUP_GEMM 1
#endif
constexpr int NWAVES = 8, NTHR = 512;
constexpr int LDS_BYTES = 131072 + 1024;

constexpr size_t MiB = 1u << 20;
constexpr size_t SZ_WGU = (size_t)2 * FF * D * 2, SZ_WD = (size_t)D * FF * 2;
constexpr size_t WS_WGU = 1 * MiB, WS_WD = WS_WGU + 4 * SZ_WGU, WS_WAIN = WS_WD + 4 * SZ_WD, WS_WBIN = WS_WAIN + (size_t)PROJ_LD * D * 2,
                 WS_WKV = WS_WBIN + (size_t)D * D * 2, WS_WMIX = WS_WKV + (size_t)2 * RW * D * 2, WS_Z = WS_WMIX + (size_t)2 * D * D * 2, WS_WEND = WS_Z + (size_t)2048 * D * 2;
static_assert(WS_WEND <= 88 * MiB, "weights region");
constexpr size_t WS_XN = 88 * MiB;
constexpr size_t WS_Y = 152 * MiB;
constexpr size_t WS_H = 216 * MiB;
constexpr size_t WS_KV = 392 * MiB;
constexpr size_t WS_CZ = 488 * MiB;
constexpr size_t WS_AGG = 496 * MiB;
constexpr size_t WS_GWT = 500 * MiB;
constexpr size_t WS_RS = 504 * MiB;
constexpr size_t WS_END = 512 * MiB;

__device__ __forceinline__ float bflo(unsigned w) { return __uint_as_float(w << 16); }
__device__ __forceinline__ float bfhi(unsigned w) { return __uint_as_float(w & 0xffff0000u); }
__device__ __forceinline__ float bf2f(bf16 v) { return __uint_as_float(((unsigned)v) << 16); }
__device__ __forceinline__ bf16 f2bf(float f) { return (bf16)(pk2(f, 0.f) & 0xffffu); }
__device__ __forceinline__ float wave_sum(float v) {
#pragma unroll
    for (int o = 1; o < 64; o <<= 1) v += __shfl_xor(v, o);
    return v;
}
#define LDS_WAIT() asm volatile("s_waitcnt lgkmcnt(0)" ::: "memory")
#define MFMA32(a, b, c) __builtin_amdgcn_mfma_f32_32x32x16_bf16((a), (b), (c), 0, 0, 0)

__device__ __forceinline__ void tr_item(const float* W, int K, int N, bf16* WT, int mode, int row_off, LAS float* scr, int item, int lane, const float* gk) {
    const int nblk = N / 32, kb = item / nblk, nb = item % nblk, k0 = 64 * kb, n0 = 32 * nb;
#pragma unroll
    for (int i = 0; i < 8; ++i) { const int kk = 8 * i + (lane >> 3); const float gsc = gk ? gk[k0 + kk] : 1.0f;
        const f32x4 v = *(const f32x4*)(W + (size_t)(k0 + kk) * N + n0 + 4 * (lane & 7)) * gsc;
        LAS float* d = scr + kk * 33 + 4 * (lane & 7); d[0] = v.x; d[1] = v.y; d[2] = v.z; d[3] = v.w; }
    LDS_WAIT(); asm volatile("" ::: "memory");
    const int rb = (mode == 0) ? (row_off + n0) : (256 * (n0 >> 7) + (n0 & 127) + (mode == 2 ? 128 : 0));
    const int c = lane & 7;
#pragma unroll
    for (int j = 0; j < 4; ++j) { const int n = (lane >> 3) + 8 * j; const LAS float* s = scr + (8 * c) * 33 + n;
        v4u o; o.x = pk2(s[0 * 33], s[1 * 33]); o.y = pk2(s[2 * 33], s[3 * 33]); o.z = pk2(s[4 * 33], s[5 * 33]); o.w = pk2(s[6 * 33], s[7 * 33]);
        *(v4u*)(WT + (size_t)(rb + n) * K + k0 + 8 * c) = o; }
    LDS_WAIT(); asm volatile("" ::: "memory");
}

template <int R, bool XIB, bool XOB>
__device__ __forceinline__ void row_jobs(const void* xin, const bf16* F, const float* gf, float coef, void* xout, const float* g1, bf16* N1, const float* g2, bf16* N2, int m0, int ms, int lane, float* rsout = nullptr) {
    f32x4 v[R][4];
    if (XIB) {
        v2u xw[R][4];
#pragma unroll
        for (int k = 0; k < R; ++k)
#pragma unroll
            for (int j = 0; j < 4; ++j) xw[k][j] = *(const v2u*)((const bf16*)xin + (size_t)(m0 + k * ms) * D + 4 * lane + 256 * j);
#pragma unroll
        for (int k = 0; k < R; ++k)
#pragma unroll
            for (int j = 0; j < 4; ++j) v[k][j] = (f32x4){bflo(xw[k][j].x), bfhi(xw[k][j].x), bflo(xw[k][j].y), bfhi(xw[k][j].y)};
    } else {
#pragma unroll
        for (int k = 0; k < R; ++k)
#pragma unroll
            for (int j = 0; j < 4; ++j) v[k][j] = *(const f32x4*)((const float*)xin + (size_t)(m0 + k * ms) * D + 4 * lane + 256 * j);
    }
    if (F) {
        v2u fw[R][4];
#pragma unroll
        for (int k = 0; k < R; ++k)
#pragma unroll
            for (int j = 0; j < 4; ++j) fw[k][j] = *(const v2u*)(F + (size_t)(m0 + k * ms) * D + 4 * lane + 256 * j);
        f32x4 gfv[4];
#pragma unroll
        for (int j = 0; j < 4; ++j) gfv[j] = *(const f32x4*)(gf + 4 * lane + 256 * j);
#pragma unroll
        for (int k = 0; k < R; ++k) {
            f32x4 f[4]; float ss = 0.f;
#pragma unroll
            for (int j = 0; j < 4; ++j) { f[j] = (f32x4){bflo(fw[k][j].x), bfhi(fw[k][j].x), bflo(fw[k][j].y), bfhi(fw[k][j].y)};
                ss += (f[j].x * f[j].x + f[j].y * f[j].y) + (f[j].z * f[j].z + f[j].w * f[j].w); }
            ss = wave_sum(ss);
            const float rf = rsqrtf(ss * (1.0f / D) + EPS) * coef;
#pragma unroll
            for (int j = 0; j < 4; ++j) v[k][j] = v[k][j] + f[j] * gfv[j] * rf;
        }
    }
    if (xout) {
#pragma unroll
        for (int k = 0; k < R; ++k)
#pragma unroll
            for (int j = 0; j < 4; ++j) {
                if (XOB) { v2u w; w.x = pk2(v[k][j].x, v[k][j].y); w.y = pk2(v[k][j].z, v[k][j].w); *(v2u*)((bf16*)xout + (size_t)(m0 + k * ms) * D + 4 * lane + 256 * j) = w; }
                else *(f32x4*)((float*)xout + (size_t)(m0 + k * ms) * D + 4 * lane + 256 * j) = v[k][j]; }
    }
    if (N1 || N2 || rsout) {
        float r[R];
#pragma unroll
        for (int k = 0; k < R; ++k) { float s2 = 0.f;
#pragma unroll
            for (int j = 0; j < 4; ++j) s2 += (v[k][j].x * v[k][j].x + v[k][j].y * v[k][j].y) + (v[k][j].z * v[k][j].z + v[k][j].w * v[k][j].w);
            r[k] = rsqrtf(wave_sum(s2) * (1.0f / D) + EPS); if (rsout && lane == 0) rsout[m0 + k * ms] = r[k]; }
        if (N1) {
#pragma unroll
            for (int j = 0; j < 4; ++j) { const f32x4 g = *(const f32x4*)(g1 + 4 * lane + 256 * j);
#pragma unroll
                for (int k = 0; k < R; ++k) { const f32x4 o = v[k][j] * g * r[k]; v2u w; w.x = pk2(o.x, o.y); w.y = pk2(o.z, o.w); *(v2u*)(N1 + (size_t)(m0 + k * ms) * D + 4 * lane + 256 * j) = w; } }
        }
        if (N2) {
#pragma unroll
            for (int j = 0; j < 4; ++j) { const f32x4 g = *(const f32x4*)(g2 + 4 * lane + 256 * j);
#pragma unroll
                for (int k = 0; k < R; ++k) { const f32x4 o = v[k][j] * g * r[k]; v2u w; w.x = pk2(o.x, o.y); w.y = pk2(o.z, o.w); *(v2u*)(N2 + (size_t)(m0 + k * ms) * D + 4 * lane + 256 * j) = w; } }
        }
    }
}
__device__ __forceinline__ void row_job(const float* xr, const bf16* fr, const float* gf, float coef, float* xo, const float* g1, bf16* n1, const float* g2, bf16* n2, int lane) {
    row_jobs<1, false, false>(xr, fr, gf, coef, xo, g1, n1, g2, n2, 0, 0, lane);
}

__device__ __forceinline__ int kappa(int rho) { return 16 * ((rho >> 2) & 1) + 4 * (rho >> 3) + (rho & 3); }
__device__ __forceinline__ bf16x8 pack8(const f32x16& w, int s) {
    v4u p; p.x = pk2(w[8 * s + 0], w[8 * s + 1]); p.y = pk2(w[8 * s + 2], w[8 * s + 3]); p.z = pk2(w[8 * s + 4], w[8 * s + 5]); p.w = pk2(w[8 * s + 6], w[8 * s + 7]);
    return __builtin_bit_cast(bf16x8, p);
}
__device__ __forceinline__ void store_o(bf16* yrow, const f32x16& o0, const f32x16& o1, float sc, int hh) {
#pragma unroll
    for (int g = 0; g < 4; ++g) {
        v2u a; a.x = pk2(o0[4 * g] * sc, o0[4 * g + 1] * sc); a.y = pk2(o0[4 * g + 2] * sc, o0[4 * g + 3] * sc); *(v2u*)(yrow + 8 * g + 4 * hh) = a;
        v2u b; b.x = pk2(o1[4 * g] * sc, o1[4 * g + 1] * sc); b.y = pk2(o1[4 * g + 2] * sc, o1[4 * g + 3] * sc); *(v2u*)(yrow + 32 + 8 * g + 4 * hh) = b;
    }
}

constexpr int MK_LD = 72, MV_LD = 264;
__device__ __forceinline__ void mem_attn_phase(LAS unsigned char* lds, const bf16* Q, int ldq, int qcol, const bf16* CZ, int l, bf16* Y, int bx, int G, int tid) {
    const int np = (G >= 8) ? 8 : 1, pair = bx % np, j = bx / np, nper = (G + np - 1 - pair) / np;
    LAS bf16* Ks = (LAS bf16*)lds; LAS bf16* Vs = Ks + 256 * MK_LD;
    int tid_o = tid; asm volatile("" : "+v"(tid_o)); tid_o &= 511;
    const int lane = tid_o & 63, wave = tid_o >> 6, r = lane & 31, hh = lane >> 5;
    for (int pr = pair; pr < 8; pr += np) {
        const int b = pr >> 2, h = pr & 3;
        __syncthreads();
#pragma unroll
        for (int it = 0; it < 4; ++it) { const int idx = tid_o + NTHR * it;
            { const int key = idx >> 3, ck = idx & 7; *(LAS v4u*)(Ks + key * MK_LD + 8 * ck) = *(const v4u*)(CZ + (size_t)(l * 512 + b * 256 + key) * 2048 + 1024 + l * 512 + h * 64 + 8 * ck); }
            { const int d = idx >> 5, ck = idx & 31; *(LAS v4u*)(Vs + d * MV_LD + 8 * ck) = *(const v4u*)(CZ + (size_t)(1024 + l * 512 + 256 + h * 64 + d) * 2048 + l * 512 + b * 256 + 8 * ck); } }
        __syncthreads();
        for (int t = j * NWAVES + wave; t < SEQ / 32; t += nper * NWAVES) {
            const size_t tok0 = (size_t)b * SEQ + t * 32;
            bf16x8 qf[4];
#pragma unroll
            for (int s = 0; s < 4; ++s) qf[s] = *(const bf16x8*)(Q + (tok0 + r) * ldq + qcol + h * 64 + 16 * s + 8 * hh);
            float mrun = -1e30f, lsum = 0.f;
            f32x16 o0, o1;
#pragma unroll
            for (int i = 0; i < 16; ++i) { o0[i] = 0.f; o1[i] = 0.f; }
#pragma unroll 2
            for (int kt = 0; kt < 8; ++kt) {
                bf16x8 kf[4], vf[2][2];
#pragma unroll
                for (int s = 0; s < 4; ++s) kf[s] = *(const LAS bf16x8*)(Ks + (kt * 32 + kappa(r)) * MK_LD + 16 * s + 8 * hh);
#pragma unroll
                for (int dt = 0; dt < 2; ++dt)
#pragma unroll
                    for (int s = 0; s < 2; ++s) vf[dt][s] = *(const LAS bf16x8*)(Vs + (dt * 32 + r) * MV_LD + kt * 32 + 16 * hh + 8 * s);
                f32x16 st;
#pragma unroll
                for (int i = 0; i < 16; ++i) st[i] = 0.f;
#pragma unroll
                for (int s = 0; s < 4; ++s) st = MFMA32(kf[s], qf[s], st);
                float mx = st[0];
#pragma unroll
                for (int i = 1; i < 16; ++i) mx = fmaxf(mx, st[i]);
                mx = fmaxf(mx, __shfl_xor(mx, 32));
                const float mnew = fmaxf(mrun, mx), alpha = __builtin_amdgcn_exp2f(mrun - mnew);
                mrun = mnew;
                float ps = 0.f;
#pragma unroll
                for (int i = 0; i < 16; ++i) { st[i] = __builtin_amdgcn_exp2f(st[i] - mnew); ps += st[i]; }
                lsum = lsum * alpha + ps;
#pragma unroll
                for (int i = 0; i < 16; ++i) { o0[i] *= alpha; o1[i] *= alpha; }
                const bf16x8 p0 = pack8(st, 0), p1 = pack8(st, 1);
                o0 = MFMA32(vf[0][0], p0, o0); o0 = MFMA32(vf[0][1], p1, o0);
                o1 = MFMA32(vf[1][0], p0, o1); o1 = MFMA32(vf[1][1], p1, o1);
            }
            const float tot = lsum + __shfl_xor(lsum, 32);
            store_o(Y + (tok0 + r) * D + RW + h * 64, o0, o1, 1.0f / tot, hh);
        }
    }
    __syncthreads();
}

__device__ __forceinline__ void sb_attn_unit(const bf16* Q, const bf16* KB, const bf16* VT, bf16* Y, int unit, int lane) {
    const int qt = unit & 511, bh = unit >> 9, h = bh % NH, b = bh / NH, r = lane & 31, hh = lane >> 5;
    const size_t tok0 = (size_t)b * SEQ + qt * 32;
    bf16x8 qf[4];
#pragma unroll
    for (int s = 0; s < 4; ++s) qf[s] = *(const bf16x8*)(Q + (tok0 + r) * D + h * 64 + 16 * s + 8 * hh);
    const bf16* Kb = KB + ((size_t)b * SEQ + kappa(r)) * RW + h * 64 + 8 * hh;
    const bf16* Vb = VT + (size_t)(h * 64 + r) * M + (size_t)b * SEQ + 16 * hh;
    float rest = 0.f;
    f32x16 o0, o1;
#pragma unroll
    for (int i = 0; i < 16; ++i) { o0[i] = 0.f; o1[i] = 0.f; }
    bf16x8 kf[4], vf[2][2];
#pragma unroll
    for (int s = 0; s < 4; ++s) kf[s] = *(const bf16x8*)(Kb + (size_t)qt * 32 * RW + 16 * s);
#pragma unroll
    for (int dt = 0; dt < 2; ++dt)
#pragma unroll
        for (int s = 0; s < 2; ++s) vf[dt][s] = *(const bf16x8*)(Vb + (size_t)dt * 32 * M + qt * 32 + 8 * s);
    for (int kt = qt; kt >= 0; --kt) {
        bf16x8 kn[4], vn[2][2];
        const int ktn = kt > 0 ? kt - 1 : 0;
#pragma unroll
        for (int s = 0; s < 4; ++s) kn[s] = *(const bf16x8*)(Kb + (size_t)ktn * 32 * RW + 16 * s);
#pragma unroll
        for (int dt = 0; dt < 2; ++dt)
#pragma unroll
            for (int s = 0; s < 2; ++s) vn[dt][s] = *(const bf16x8*)(Vb + (size_t)dt * 32 * M + ktn * 32 + 8 * s);
        f32x16 z;
#pragma unroll
        for (int i = 0; i < 16; ++i) z[i] = 0.f;
#pragma unroll
        for (int s = 0; s < 4; ++s) z = MFMA32(kf[s], qf[s], z);
        float t[16];
#pragma unroll
        for (int i = 0; i < 16; ++i) t[i] = __builtin_amdgcn_exp2f(fminf(z[i], 30.0f));
        if (kt == qt) {
#pragma unroll
            for (int i = 0; i < 16; ++i) t[i] = (16 * hh + i < r) ? t[i] : 0.f;
        }
        float lg[4]; f32x16 w;
#pragma unroll
        for (int g = 0; g < 4; ++g) {
            const float u0 = 1.f + t[4 * g], u1 = 1.f + t[4 * g + 1], u2 = 1.f + t[4 * g + 2], u3 = 1.f + t[4 * g + 3];
            const float p1 = u0, p2 = p1 * u1, p3 = p2 * u2, G = p3 * u3;
            lg[g] = __builtin_amdgcn_logf(G);
            w[4 * g] = t[4 * g]; w[4 * g + 1] = t[4 * g + 1] * p1; w[4 * g + 2] = t[4 * g + 2] * p2; w[4 * g + 3] = t[4 * g + 3] * p3;
        }
        const float LT = (lg[0] + lg[1]) + (lg[2] + lg[3]);
        const float OT = __shfl_xor(LT, 32);
        float sg = rest - (hh == 0 ? OT : 0.f);
#pragma unroll
        for (int g = 3; g >= 0; --g) { sg -= lg[g]; const float e = __builtin_amdgcn_exp2f(sg);
            w[4 * g] *= e; w[4 * g + 1] *= e; w[4 * g + 2] *= e; w[4 * g + 3] *= e; }
        rest = rest - LT - OT;
        const bf16x8 p0 = pack8(w, 0), p1 = pack8(w, 1);
        o0 = MFMA32(vf[0][0], p0, o0); o0 = MFMA32(vf[0][1], p1, o0);
        o1 = MFMA32(vf[1][0], p0, o1); o1 = MFMA32(vf[1][1], p1, o1);
        if (__all(rest < -32.0f)) break;
#pragma unroll
        for (int s = 0; s < 4; ++s) kf[s] = kn[s];
        vf[0][0] = vn[0][0]; vf[0][1] = vn[0][1]; vf[1][0] = vn[1][0]; vf[1][1] = vn[1][1];
    }
    store_o(Y + (tok0 + r) * D + h * 64, o0, o1, 1.0f, hh);
}

__device__ __forceinline__ void scan_a_unit(LAS unsigned char* lds, const bf16* PROJ, const float* conv_w, const float* conv_b, const bf16* GWT, const float* gate_b,
                                            const float* lam, bf16* HL, bf16* PP, float* AGG, int unit, int tid) {
    const int n = unit % NBLK, c = (unit / NBLK) % NCHUNK, b = unit / (NBLK * NCHUNK);
    LAS float* xr = (LAS float*)lds;
    LAS float* xc = (LAS float*)(lds + 34816);
    LAS bf16* xcb = (LAS bf16*)(lds + 34816 + 32768);
    LAS bf16* wt = xcb + 128 * 72;
    LAS float* part = (LAS float*)(wt + 128 * 72);
    const int t0 = c * TC;
    const size_t tokbase = (size_t)b * SEQ + t0;
    { unsigned xw[9]; v4u gw_[2];
#pragma unroll
      for (int it = 0; it < 9; ++it) { const int idx = tid + NTHR * it, row = idx >> 5, cp = idx & 31, t = t0 - 3 + row; xw[it] = 0u;
        if (idx < 131 * 32 && t >= 0) xw[it] = *(const unsigned*)(PROJ + ((size_t)b * SEQ + t) * PROJ_LD + n * 64 + 2 * cp); }
#pragma unroll
      for (int it = 0; it < 2; ++it) { const int idx = tid + NTHR * it, row = idx >> 3, ck = idx & 7; gw_[it] = *(const v4u*)(GWT + (size_t)n * 8192 + row * 64 + 8 * ck); }
#pragma unroll
      for (int it = 0; it < 9; ++it) { const int idx = tid + NTHR * it, row = idx >> 5, cp = idx & 31;
        if (idx < 131 * 32) { xr[row * 64 + 2 * cp] = bflo(xw[it]); xr[row * 64 + 2 * cp + 1] = bfhi(xw[it]); } }
#pragma unroll
      for (int it = 0; it < 2; ++it) { const int idx = tid + NTHR * it, row = idx >> 3, ck = idx & 7; *(LAS v4u*)(wt + row * 72 + 8 * ck) = gw_[it]; } }
    __syncthreads();
    { const int ch = tid & 63, sub = tid >> 6, col = n * 64 + ch;
      const float w0 = conv_w[col], w1 = conv_w[RW + col], w2 = conv_w[2 * RW + col], w3 = conv_w[3 * RW + col], cb = conv_b[col];
#pragma unroll
      for (int i = 0; i < 16; ++i) { const int t = sub * 16 + i;
        const float v = cb + w0 * xr[t * 64 + ch] + w1 * xr[(t + 1) * 64 + ch] + w2 * xr[(t + 2) * 64 + ch] + w3 * xr[(t + 3) * 64 + ch];
        xc[t * 64 + ch] = v; xcb[t * 72 + ch] = f2bf(v); } }
    __syncthreads();
    const int wv = tid >> 6, lane = tid & 63, c32 = lane & 31, hh = lane >> 5, tg = wv >> 1, ch = 32 * (wv & 1) + c32, sub = 2 * tg + hh, col = n * 64 + ch;
    f32x16 ar, ai;
    { const float br = gate_b[col], bi = gate_b[RW + col];
#pragma unroll
      for (int i = 0; i < 16; ++i) { ar[i] = br; ai[i] = bi; } }
#pragma unroll
    for (int s = 0; s < 4; ++s) {
        const bf16x8 af = *(const LAS bf16x8*)(xcb + (32 * tg + kappa(c32)) * 72 + 16 * s + 8 * hh);
        const bf16x8 br_ = *(const LAS bf16x8*)(wt + ch * 72 + 16 * s + 8 * hh), bi_ = *(const LAS bf16x8*)(wt + (64 + ch) * 72 + 16 * s + 8 * hh);
        ar = MFMA32(af, br_, ar); ai = MFMA32(af, bi_, ai);
    }
    const float c8 = -8.0f * LOG2E * log1pf(expf(-lam[col]));
    float hl[16], pp[16]; float hcur = 0.f, pcur = 1.f;
#pragma unroll
    for (int i = 0; i < 16; ++i) {
        const float rg = __builtin_amdgcn_rcpf(1.0f + __builtin_amdgcn_exp2f(-LOG2E * ar[i])), ig = __builtin_amdgcn_rcpf(1.0f + __builtin_amdgcn_exp2f(-LOG2E * ai[i]));
        const float a = __builtin_amdgcn_exp2f(c8 * rg), mult = __builtin_amdgcn_sqrtf(fmaxf(1.0f - a * a, 0.0f));
        hcur = a * hcur + mult * ig * xc[(sub * 16 + i) * 64 + ch]; pcur *= a; hl[i] = hcur; pp[i] = pcur; }
    part[(sub * 64 + ch) * 2] = pcur; part[(sub * 64 + ch) * 2 + 1] = hcur;
    __syncthreads();
    float hc = 0.f, pc = 1.f;
    for (int s = 0; s < sub; ++s) { const float ps = part[(s * 64 + ch) * 2], hs = part[(s * 64 + ch) * 2 + 1]; hc = ps * hc + hs; pc *= ps; }
#pragma unroll
    for (int i = 0; i < 16; ++i) { hl[i] += pp[i] * hc; pp[i] *= pc; }
#pragma unroll
    for (int i = 0; i < 16; ++i) { const size_t o = (tokbase + sub * 16 + i) * RW + col; HL[o] = f2bf(hl[i]); PP[o] = f2bf(pp[i]); }
    if (sub == 7) { float* ag = AGG + ((size_t)(b * NCHUNK + c) * RW + col) * 2; ag[0] = pp[15]; ag[1] = hl[15]; }
    __syncthreads();
}
__device__ __forceinline__ void scan_c_unit(LAS unsigned char* lds, const bf16* PROJ, const bf16* HL, const bf16* PP, const float* AGG, bf16* Y, int unit, int tid) {
    const int n = unit % NBLK, c = (unit / NBLK) % NCHUNK, b = unit / (NBLK * NCHUNK);
    LAS float* part = (LAS float*)lds;
    LAS float* carryL = part + 1024;
    const int ch = tid & 63, sub = tid >> 6, col = n * 64 + ch;
    const size_t tokbase = (size_t)b * SEQ + c * TC;
    { mk_f32x2_t ag[16];
#pragma unroll
      for (int k = 0; k < 16; ++k) ag[k] = *(const mk_f32x2_t*)(AGG + ((size_t)(b * NCHUNK + sub * 16 + k) * RW + col) * 2);
      float pq = 1.f, hq = 0.f;
#pragma unroll
      for (int k = 0; k < 16; ++k) { const bool use = (sub * 16 + k) < c; const float pa = use ? ag[k].x : 1.f, ha = use ? ag[k].y : 0.f; hq = pa * hq + ha; pq *= pa; }
      part[(sub * 64 + ch) * 2] = pq; part[(sub * 64 + ch) * 2 + 1] = hq; }
    __syncthreads();
    if (tid < 64) { float carry = 0.f;
#pragma unroll
        for (int s = 0; s < 8; ++s) carry = part[(s * 64 + tid) * 2] * carry + part[(s * 64 + tid) * 2 + 1];
        carryL[tid] = carry; }
    __syncthreads();
#pragma unroll
    for (int it = 0; it < 2; ++it) { const int item = tid + NTHR * it, tok = item >> 3, ck = item & 7;
        const size_t row = tokbase + tok;
        const v4u hv = *(const v4u*)(HL + row * RW + n * 64 + 8 * ck), pv = *(const v4u*)(PP + row * RW + n * 64 + 8 * ck), gv = *(const v4u*)(PROJ + row * PROJ_LD + RW + n * 64 + 8 * ck);
        float y[8];
#pragma unroll
        for (int q = 0; q < 4; ++q) {
#pragma unroll
            for (int hf = 0; hf < 2; ++hf) {
                const float hl_ = hf ? bfhi(hv[q]) : bflo(hv[q]), pp_ = hf ? bfhi(pv[q]) : bflo(pv[q]), xg = hf ? bfhi(gv[q]) : bflo(gv[q]);
                const float hfull = hl_ + pp_ * carryL[8 * ck + 2 * q + hf];
                const float uu = 0.7978845608f * (xg + 0.044715f * xg * xg * xg);
                y[2 * q + hf] = xg * __builtin_amdgcn_rcpf(1.0f + __builtin_amdgcn_exp2f(-2.0f * LOG2E * uu)) * hfull; } }
        v4u o; o.x = pk2(y[0], y[1]); o.y = pk2(y[2], y[3]); o.z = pk2(y[4], y[5]); o.w = pk2(y[6], y[7]);
        *(v4u*)(Y + row * D + n * 64 + 8 * ck) = o; }
    __syncthreads();
}

#define XB_TMO      128
#define XB_XCNT(j)  (256  + 64 * (j))
#define XB_XSUB(j)  (1280 + 64 * (j))
#define XB_XGEN(j)  (2304 + 64 * (j))
#define XB_TOP      3328
#define XB_TOPGEN   3392
#define XCD_BAR_WORDS 3456
#define XB_SPIN_CAP (1u << 18)

__device__ __forceinline__ unsigned xb_ld(unsigned* p)              { return __hip_atomic_load(p, __ATOMIC_RELAXED, __HIP_MEMORY_SCOPE_AGENT); }
__device__ __forceinline__ unsigned xb_add(unsigned* p, unsigned v) { return __hip_atomic_fetch_add(p, v, __ATOMIC_RELAXED, __HIP_MEMORY_SCOPE_AGENT); }
__device__ __forceinline__ unsigned xb_xcc_id() { return (unsigned)__builtin_amdgcn_s_getreg((3 << 11) | 20) & 0xFu; }
#define XB_SPIN(cond, bar) do { unsigned _sp = 0; while (cond) { __builtin_amdgcn_s_sleep(1); \
    if ((++_sp & 255u) == 0u) { if (xb_ld(&(bar)[XB_TMO])) break; if (_sp > XB_SPIN_CAP) { atomicAdd(&(bar)[XB_TMO], 1u); break; } } } } while (0)

struct XcdBarrier {
    unsigned* bar; unsigned x;
    volatile LAS unsigned* st;
};

__device__ __forceinline__ XcdBarrier xcd_barrier_post(unsigned* bar, volatile LAS unsigned* st) {
    XcdBarrier b; b.bar = bar; b.x = xb_xcc_id(); b.st = st;
    if (threadIdx.x == 0) (void)xb_add(&bar[XB_XCNT(b.x)], 1u);
    return b;
}
__device__ __forceinline__ void xcd_barrier_complete(unsigned* bar, unsigned x, unsigned& nloc, unsigned& nx) {
    const unsigned G = gridDim.x * gridDim.y * gridDim.z;
    unsigned sum, cnt, mine, sp = 0u;
    for (;;) {
        sum = 0u; cnt = 0u; mine = 0u;
#pragma unroll
        for (unsigned j = 0; j < 16; ++j) { const unsigned c = xb_ld(&bar[XB_XCNT(j)]); sum += c; cnt += (c > 0u) ? 1u : 0u; mine = (j == x) ? c : mine; }
        if (sum == G) break;
        __builtin_amdgcn_s_sleep(1);
        if ((++sp & 255u) == 0u) { if (xb_ld(&bar[XB_TMO])) break; if (sp > XB_SPIN_CAP) { atomicAdd(&bar[XB_TMO], 1u); break; } }
    }
    nloc = mine > 0u ? mine : 1u; nx = cnt > 0u ? cnt : 1u;
}

__device__ __forceinline__ void xcd_barrier(const XcdBarrier& b) {
    asm volatile("s_waitcnt vmcnt(0)" ::: "memory");
    __syncthreads();
    if (threadIdx.x == 0) {
        unsigned* bar = b.bar;
        __builtin_amdgcn_s_waitcnt(0);
        unsigned nloc = b.st[0], nx = b.st[1];
        if (nloc == 0u) { xcd_barrier_complete(bar, b.x, nloc, nx); b.st[0] = nloc; b.st[1] = nx; }
        const unsigned old = xb_add(&bar[XB_XSUB(b.x)], 1u);
        const unsigned gen = old / nloc;
        if (old + 1u == (gen + 1u) * nloc) {
            __builtin_amdgcn_fence(__ATOMIC_RELEASE, "agent");
            asm volatile("s_waitcnt vmcnt(0)" ::: "memory");
            const unsigned og = xb_add(&bar[XB_TOP], 1u);
            const unsigned tg = og / nx;
            if (og + 1u == (tg + 1u) * nx) xb_add(&bar[XB_TOPGEN], 1u);
            else XB_SPIN(xb_ld(&bar[XB_TOPGEN]) == tg, bar);
            __builtin_amdgcn_fence(__ATOMIC_ACQUIRE, "agent");
            xb_add(&bar[XB_XGEN(b.x)], 1u);
            asm volatile("s_waitcnt vmcnt(0)" ::: "memory");
        } else {
            XB_SPIN(xb_ld(&bar[XB_XGEN(b.x)]) == gen, bar);
            __builtin_amdgcn_fence(__ATOMIC_ACQUIRE, "agent");
            asm volatile("s_waitcnt vmcnt(0)" ::: "memory");
        }
    }
    __syncthreads();
}


#define KARG_ ((const unsigned char __attribute__((address_space(4)))*)__builtin_amdgcn_kernarg_segment_ptr())
#define IN_(i) (*(const float* const __attribute__((address_space(4)))*)(KARG_ + 8 * (i)))
#define OUT_ (*(float* const __attribute__((address_space(4)))*)(KARG_ + 144))
#define WSP_ (*(unsigned char* const __attribute__((address_space(4)))*)(KARG_ + 152))
struct Args { const float* in[18]; float* out; unsigned char* ws; int cg_sync; int pad; };
__global__ void __launch_bounds__(NTHR, 2) yoco_fwd(Args args) {
    extern __shared__ __attribute__((aligned(16))) unsigned char lds_raw[];
    LAS unsigned char* lds = (LAS unsigned char*)lds_raw;
    cg::grid_group grid = cg::this_grid();
    if (threadIdx.x < 256) ((LAS unsigned*)(lds + 131072))[threadIdx.x] = 0u;
    __syncthreads();
    const XcdBarrier xbar = xcd_barrier_post((unsigned*)WSP_, (volatile LAS unsigned*)(lds + 131072));
    const int tid = threadIdx.x, lane = tid & 63, wave = __builtin_amdgcn_readfirstlane(tid >> 6);
    const int G = gridDim.x, bx = blockIdx.x;
    const int gw = bx * NWAVES + wave, ngw = G * NWAVES;
#define WSB(off) ((bf16*)(WSP_ + (off)))
#define GEMM(KC, Aptr, Bptr, Mm, Nn, cid, Optr, ldo, scl, from, md, rsp, rsm) do { pg8::Gemm g_{(const pg8::bf16_t*)(Aptr), (const pg8::bf16_t*)(Bptr), (Mm), (Nn), (KC)}; pg8::StaticOrder S_; S_.init((Mm), (Nn), G, (cid)); \
        pg8::EpiU E_{(pg8::bf16_t*)(Optr), (ldo), (scl), (from), (md), (rsp), (rsm)}; pg8::gemm_phase<pg8::EpiU, pg8::StaticOrder, true, true, (KC)>(lds, g_, S_, E_); if (DUP_GEMM > 1) { asm volatile("" ::: "memory"); pg8::gemm_phase<pg8::EpiU, pg8::StaticOrder, true, true, (KC)>(lds, g_, S_, E_); } } while (0)
#define ROWS(XIB, XOB, xin, xout, gf, coef, rso) do { OPQ_IDS for (int m = gw; m < M; m += ROWS_R * ngw) row_jobs<ROWS_R, XIB, XOB>((xin), WSB(WS_XN), (gf), (coef), (xout), (const float*)nullptr, (bf16*)nullptr, (const float*)nullptr, (bf16*)nullptr, m, ngw, lane, (rso)); } while (0)
#define RS_ ((float*)(WSP_ + WS_RS))
#define XB_ ((bf16*)OUT_ + (size_t)M * D)
#define XB2_ WSB(WS_Y)
#define GSYNC() do { xcd_barrier(xbar); if (DUP_SYNC > 1) xcd_barrier(xbar); } while (0)
#define DUPX(n, ...) do { OPQ_IDS __VA_ARGS__; if ((n) > 1) { asm volatile("" ::: "memory"); __VA_ARGS__; } if ((n) > 2) { asm volatile("" ::: "memory"); __VA_ARGS__; } } while (0)
#define OPQ_IDS int tid_o = threadIdx.x; asm volatile("" : "+v"(tid_o)); tid_o &= 511; const int tid = tid_o, lane = tid_o & 63; (void)tid; (void)lane;
#define NORMG(l, k) (IN_(5) + ((l) * 6 + (k)) * D)
    constexpr int NOSC = 1 << 30;
    for (int rep_ = 0; rep_ < DUP_PRO; ++rep_) {
        OPQ_IDS
        LAS float* scr = (LAS float*)(lds + wave * 16384);
        constexpr int I_FF = 16 * 88, I_DN = 44 * 32, I_AIN = 16 * 56, I_BIN = 16 * 32, I_KV = 16 * 48, I_MIX = 16 * 32, I_MKV = 16 * 16;
        constexpr int NITEMS = 12 * I_FF + I_AIN + I_BIN + I_KV + 2 * I_MIX + 2 * I_MKV;
        static_assert(I_FF == I_DN, "item counts");
        for (int it = gw; it < NITEMS; it += ngw) {
            int r = it; const float* W; int K = D, N = D, mode = 0; bf16* WT; const float* gk = nullptr;
            if (r < 4 * I_FF) { const int sub = r / I_FF; W = IN_(2) + (size_t)sub * D * FF; N = FF; WT = WSB(WS_WGU) + (size_t)sub * 2 * FF * D; mode = 1; r %= I_FF; gk = NORMG(sub >> 1, (sub & 1) ? 4 : 0); }
            else if ((r -= 4 * I_FF) < 4 * I_FF) { const int sub = r / I_FF; W = IN_(3) + (size_t)sub * D * FF; N = FF; WT = WSB(WS_WGU) + (size_t)sub * 2 * FF * D; mode = 2; r %= I_FF; gk = NORMG(sub >> 1, (sub & 1) ? 4 : 0); }
            else if ((r -= 4 * I_FF) < 4 * I_DN) { const int sub = r / I_DN; W = IN_(4) + (size_t)sub * FF * D; K = FF; WT = WSB(WS_WD) + (size_t)sub * D * FF; r %= I_DN; }
            else if ((r -= 4 * I_DN) < I_AIN) { W = IN_(9); N = PROJ_LD; WT = WSB(WS_WAIN); gk = NORMG(0, 2); }
            else if ((r -= I_AIN) < I_BIN) { W = IN_(15); WT = WSB(WS_WBIN); gk = NORMG(1, 2); }
            else if ((r -= I_BIN) < I_KV) { W = IN_(17); N = 2 * RW; WT = WSB(WS_WKV); gk = IN_(16); }
            else if ((r -= I_KV) < 2 * I_MIX) { const int sub = r / I_MIX; W = IN_(8) + (size_t)sub * D * D; WT = WSB(WS_WMIX) + (size_t)sub * D * D; r %= I_MIX; }
            else { r -= 2 * I_MIX; const int sub = r / I_MKV; W = IN_(7) + (size_t)sub * D * 512; N = 512; WT = WSB(WS_Z) + (size_t)(1024 + sub * 512) * D; r %= I_MKV; }
            tr_item(W, K, N, WT, mode, 0, scr, r, lane, gk);
        }
        for (int idx = gw * 64 + lane; idx < 12 * 128 * 64; idx += ngw * 64) { const int in_ = idx & 63, row = (idx >> 6) & 127, nn = idx >> 13, g_ = row >> 6, out_ = row & 63;
            WSB(WS_GWT)[idx] = f2bf(IN_(12)[((size_t)(g_ * NBLK + nn) * 64 + in_) * 64 + out_]); }
        for (int j = gw; j < 1024; j += ngw) { const int l = j >> 9, rr = j & 511; row_job(IN_(1) + (size_t)rr * D, nullptr, nullptr, 0.f, nullptr, IN_(6) + l * D, WSB(WS_Z) + (size_t)j * D, nullptr, nullptr, lane); }
        for (int m = gw; m < M; m += ROWS_R * ngw) row_jobs<ROWS_R, false, true>(IN_(0), (const bf16*)nullptr, (const float*)nullptr, 0.f, XB_, (const float*)nullptr, (bf16*)nullptr, (const float*)nullptr, (bf16*)nullptr, m, ngw, lane, RS_);
    }
    if (*(const int __attribute__((address_space(4)))*)(KARG_ + 160)) grid.sync();
    GSYNC();
    GEMM(D, XB_, WSB(WS_WGU), M, 2 * FF, bx, WSB(WS_H), FF, 1.0f, NOSC, 1, RS_, 1);
    GSYNC();
    GEMM(FF, WSB(WS_H), WSB(WS_WD), M, D, bx, WSB(WS_XN), D, 1.0f, NOSC, 0, (const float*)nullptr, 0);
    GSYNC();
    ROWS(false, true, IN_(0), XB_, NORMG(0, 1), 0.5f, RS_);
    GSYNC();
    GEMM(D, XB_, WSB(WS_WAIN), M, PROJ_LD, bx, WSB(WS_H), PROJ_LD, QSCALE, 6, 0, RS_, 1);
    GEMM(D, WSB(WS_Z), WSB(WS_Z), 2048, 2048, (bx + 64) % G, WSB(WS_CZ), 2048, 1.0f, NOSC, 0, (const float*)nullptr, 0);
    GSYNC();
    { OPQ_IDS for (int u = bx; u < NB * NCHUNK * NBLK; u += G) scan_a_unit(lds, WSB(WS_H), IN_(10), IN_(11), WSB(WS_GWT), IN_(13), IN_(14), WSB(WS_KV), WSB(WS_KV) + (size_t)M * RW, (float*)(WSP_ + WS_AGG), u, tid); }
    if (DUP_SA > 1) { asm volatile("" ::: "memory"); for (int u = bx; u < NB * NCHUNK * NBLK; u += G) scan_a_unit(lds, WSB(WS_H), IN_(10), IN_(11), WSB(WS_GWT), IN_(13), IN_(14), WSB(WS_KV), WSB(WS_KV) + (size_t)M * RW, (float*)(WSP_ + WS_AGG), u, tid); }
    if (DUP_SA > 2) { asm volatile("" ::: "memory"); for (int u = bx; u < NB * NCHUNK * NBLK; u += G) scan_a_unit(lds, WSB(WS_H), IN_(10), IN_(11), WSB(WS_GWT), IN_(13), IN_(14), WSB(WS_KV), WSB(WS_KV) + (size_t)M * RW, (float*)(WSP_ + WS_AGG), u, tid); }
    GSYNC();
    DUPX(DUP_SC, for (int u = bx; u < NB * NCHUNK * NBLK; u += G) scan_c_unit(lds, WSB(WS_H), WSB(WS_KV), WSB(WS_KV) + (size_t)M * RW, (const float*)(WSP_ + WS_AGG), WSB(WS_Y), u, tid));
    mem_attn_phase(lds, WSB(WS_H), PROJ_LD, 2 * RW, WSB(WS_CZ), 0, WSB(WS_Y), bx, G, tid);
    GSYNC();
    GEMM(D, WSB(WS_Y), WSB(WS_WMIX), M, D, bx, WSB(WS_XN), D, 1.0f, NOSC, 0, (const float*)nullptr, 0);
    GSYNC();
    ROWS(true, true, XB_, XB_, NORMG(0, 3), 1.0f, RS_);
    GSYNC();
    GEMM(D, XB_, WSB(WS_WGU) + (size_t)1 * 2 * FF * D, M, 2 * FF, bx, WSB(WS_H), FF, 1.0f, NOSC, 1, RS_, 1);
    GSYNC();
    GEMM(FF, WSB(WS_H), WSB(WS_WD) + (size_t)1 * D * FF, M, D, bx, WSB(WS_XN), D, 1.0f, NOSC, 0, (const float*)nullptr, 0);
    GSYNC();
    ROWS(true, true, XB_, XB_, NORMG(0, 5), 0.5f, RS_);
    GSYNC();
    GEMM(D, XB_, WSB(WS_WKV), M, RW, bx, WSB(WS_KV), RW, 1.0f, NOSC, 0, RS_, 1);
    GEMM(D, WSB(WS_WKV) + (size_t)RW * D, XB_, RW, M, (bx + G / 2) % G, WSB(WS_KV) + (size_t)M * RW, M, 1.0f, NOSC, 0, RS_, 2);
    GEMM(D, XB_, WSB(WS_WGU) + (size_t)2 * 2 * FF * D, M, 2 * FF, bx, WSB(WS_H), FF, 1.0f, NOSC, 1, RS_, 1);
    GSYNC();
    GEMM(FF, WSB(WS_H), WSB(WS_WD) + (size_t)2 * D * FF, M, D, bx, WSB(WS_XN), D, 1.0f, NOSC, 0, (const float*)nullptr, 0);
    GSYNC();
    ROWS(true, true, XB_, XB_, NORMG(1, 1), 0.5f, RS_);
    GSYNC();
    GEMM(D, XB_, WSB(WS_WBIN), M, D, bx, WSB(WS_H), D, QSCALE, 0, 0, RS_, 1);
    GSYNC();
    DUPX(DUP_SB, for (int u = gw; u < NB * NH * 512; u += ngw) sb_attn_unit(WSB(WS_H), WSB(WS_KV), WSB(WS_KV) + (size_t)M * RW, WSB(WS_Y), u, lane));
    mem_attn_phase(lds, WSB(WS_H), D, RW, WSB(WS_CZ), 1, WSB(WS_Y), bx, G, tid);
    GSYNC();
    GEMM(D, WSB(WS_Y), WSB(WS_WMIX) + (size_t)D * D, M, D, bx, WSB(WS_XN), D, 1.0f, NOSC, 0, (const float*)nullptr, 0);
    GSYNC();
    ROWS(true, true, XB_, XB2_, NORMG(1, 3), 1.0f, RS_);
    GSYNC();
    GEMM(D, XB2_, WSB(WS_WGU) + (size_t)3 * 2 * FF * D, M, 2 * FF, bx, WSB(WS_H), FF, 1.0f, NOSC, 1, RS_, 1);
    GSYNC();
    GEMM(FF, WSB(WS_H), WSB(WS_WD) + (size_t)3 * D * FF, M, D, bx, WSB(WS_XN), D, 1.0f, NOSC, 0, (const float*)nullptr, 0);
    GSYNC();
    ROWS(true, false, XB2_, OUT_, NORMG(1, 5), 0.5f, (float*)nullptr);
}

#undef IN_
#undef XB_
#undef RS_
#undef XB2_
#undef OUT_
#undef WSP_
extern "C" void kernel_launch(void* const* d_in, const int* in_sizes, int n_in, void* d_out, int out_size, void* d_ws, size_t ws_size, hipStream_t stream) {
    static int grid = 0;
    if (grid == 0) {
        if (n_in != 18 || out_size != M * D || ws_size < WS_END) { fprintf(stderr, "kernel_launch: unexpected shapes (n_in %d out %d ws %zu)\n", n_in, out_size, ws_size); grid = -1; return; }
        int dev = 0, cus = 0, per_cu = 0;
        hipGetDevice(&dev); hipDeviceGetAttribute(&cus, hipDeviceAttributeMultiprocessorCount, dev);
        if (hipFuncSetAttribute((const void*)yoco_fwd, hipFuncAttributeMaxDynamicSharedMemorySize, LDS_BYTES) != hipSuccess) { fprintf(stderr, "kernel_launch: hipFuncSetAttribute failed\n"); grid = -1; return; }
        if (hipOccupancyMaxActiveBlocksPerMultiprocessor(&per_cu, (const void*)yoco_fwd, NTHR, LDS_BYTES) != hipSuccess || per_cu < 1) { fprintf(stderr, "kernel_launch: occupancy query says %d\n", per_cu); per_cu = 1; }
        (void)hipGetLastError();
        grid = cus;
    }
    if (grid < 0) return;
    if (hipMemsetAsync(d_ws, 0, XCD_BAR_WORDS * 4, stream) != hipSuccess) { fprintf(stderr, "kernel_launch: memset of the barrier words failed\n"); return; }
    Args a{};
    for (int i = 0; i < 18; ++i) a.in[i] = (const float*)d_in[i];
    a.out = (float*)d_out; a.ws = (unsigned char*)d_ws;
    void* kargs[] = {&a};
    hipError_t e = hipLaunchCooperativeKernel((const void*)yoco_fwd, dim3(grid), dim3(NTHR), kargs, LDS_BYTES, stream);
    if (e != hipSuccess) fprintf(stderr, "kernel_launch: cooperative launch failed: %s (grid %d)\n", hipGetErrorString(e), grid);
}
```

```cpp
#include <hip/hip_runtime.h>
#include <hip/hip_cooperative_groups.h>
#include <cstdio>
#include <cstdint>
namespace cg = cooperative_groups;

typedef __bf16 mk_bf16x2_t __attribute__((ext_vector_type(2)));
typedef float mk_f32x2_t __attribute__((ext_vector_type(2)));
__device__ __forceinline__ unsigned pk2(float a, float b) { mk_f32x2_t v = {a, b}; mk_bf16x2_t r = __builtin_convertvector(v, mk_bf16x2_t); return __builtin_bit_cast(unsigned, r); }

namespace pg8 {
#define PG8_LAS __attribute__((address_space(3)))
typedef unsigned short bf16_t;
typedef short bf16x8 __attribute__((ext_vector_type(8)));
typedef float f32x4 __attribute__((ext_vector_type(4)));
typedef unsigned u32x4 __attribute__((ext_vector_type(4)));
constexpr int BM = 256, BK = 64, HALF = 128, HTB = HALF * BK * 2  , STAGE_BYTES = 8 * HTB, NXCD = 8, WGM = 4;

__host__ __device__ __forceinline__ int lds_byte(int r, int c) { const int st = (r >> 4) * 2 + (c >> 5), rr = r & 15, cc = c & 31, ob = rr * 64 + cc * 2; return st * 1024 + (ob ^ (((ob >> 9) & 1) << 5)); }
__host__ __device__ __forceinline__ void stage_rc(int b, int& R, int& C) { const int st = b / 1024, sb = b % 1024, swz = sb ^ (((sb >> 9) & 1) << 5); R = (st >> 1) * 16 + swz / 64; C = (st & 1) * 32 + (swz % 64) / 2; }
__host__ __device__ __forceinline__ int perm32(int rho) { const int n = rho >> 4, i = rho & 15; return 8 * (i >> 2) + 4 * n + (i & 3); }

struct Unit { int pm, pn; };
struct Gemm { const bf16_t* A; const bf16_t* Bt; int M, N, K; };

struct StaticOrder {
    int nM, nN, nwg, G, c;
    __host__ __device__ void init(int M, int N, int G_, int c_) { nM = M / BM; nN = N / BM; nwg = nM * nN; G = G_; c = c_; }
    __host__ __device__ bool next(int i, Unit& u) const {
        const long L = (long)i * G + c; if (L >= nwg) return false;
        int wgid = (int)L; { const int q = nwg / NXCD, r = nwg % NXCD, xcd = wgid % NXCD, off = wgid / NXCD; wgid = (xcd < r ? xcd * (q + 1) : r * (q + 1) + (xcd - r) * q) + off; }
        const int nig = WGM * nN, gid = wgid / nig, fm = gid * WGM, gsz = (nM - fm) < WGM ? (nM - fm) : WGM;
        u.pm = fm + ((wgid % nig) % gsz); u.pn = (wgid % nig) / gsz; return true;
    }
    __device__ __forceinline__ void a_ready(const Unit&) const {}
    __device__ __forceinline__ void done(const Unit&) const {}
};

struct EpiBf16S {
    static constexpr bool PERM = true, AFTER_DRAIN = false;
    bf16_t* O; int ldc; float scale; int scale_from_pn; const float* rs; int rs_mode;
    __device__ __forceinline__ void operator()(const f32x4 (&acc)[2][2][4][2], const Unit& u, int wr, int wc, int fr, int fq) const {
        const float s = (u.pn >= scale_from_pn) ? scale : 1.0f;
        int fr_ = fr, fq_ = fq; asm volatile("" : "+v"(fr_), "+v"(fq_));
        const int row0 = u.pm * BM + wr * 64 + fr_, col0 = u.pn * BM + wc * 32 + 8 * fq_;
        f32x4 c0[2], c1[2];
#pragma unroll
        for (int bj = 0; bj < 2; ++bj) { c0[bj] = (f32x4){s, s, s, s}; c1[bj] = c0[bj];
            if (rs_mode == 2) { c0[bj] = *(const f32x4*)(rs + col0 + bj * HALF) * s; c1[bj] = *(const f32x4*)(rs + col0 + bj * HALF + 4) * s; } }
#pragma unroll
        for (int ai = 0; ai < 2; ++ai)
#pragma unroll
            for (int m = 0; m < 4; ++m) { const int row = row0 + ai * HALF + m * 16; bf16_t* rowp = O + (size_t)row * ldc + col0;
                const float sr = (rs_mode == 1) ? rs[row] : 1.0f;
#pragma unroll
                for (int bj = 0; bj < 2; ++bj) { const f32x4 v0 = acc[ai][bj][m][0] * (c0[bj] * sr), v1 = acc[ai][bj][m][1] * (c1[bj] * sr);
                    u32x4 w; w.x = pk2(v0[0], v0[1]); w.y = pk2(v0[2], v0[3]); w.z = pk2(v1[0], v1[1]); w.w = pk2(v1[2], v1[3]);
                    *(u32x4*)(rowp + bj * HALF) = w; } }
    }
};
struct EpiSwiGLU {
    static constexpr bool PERM = true, AFTER_DRAIN = false;
    bf16_t* O; int ldc; const float* rs;
    __device__ __forceinline__ void operator()(const f32x4 (&acc)[2][2][4][2], const Unit& u, int wr, int wc, int fr, int fq) const {
        int fr_ = fr, fq_ = fq; asm volatile("" : "+v"(fr_), "+v"(fq_));
        const int row0 = u.pm * BM + wr * 64 + fr_, col0 = u.pn * HALF + wc * 32 + 8 * fq_;
#pragma unroll
        for (int ai = 0; ai < 2; ++ai)
#pragma unroll
            for (int m = 0; m < 4; ++m) { const int row = row0 + ai * HALF + m * 16; bf16_t* rowp = O + (size_t)row * ldc + col0;
                const float sr = rs[row];
                float h[8];
#pragma unroll
                for (int n = 0; n < 2; ++n)
#pragma unroll
                    for (int j = 0; j < 4; ++j) { const float g = acc[ai][0][m][n][j] * sr, up = acc[ai][1][m][n][j] * sr;
                        h[4 * n + j] = g * __builtin_amdgcn_rcpf(1.0f + __builtin_amdgcn_exp2f(-1.44269504f * g)) * up; }
                u32x4 w; w.x = pk2(h[0], h[1]); w.y = pk2(h[2], h[3]); w.z = pk2(h[4], h[5]); w.w = pk2(h[6], h[7]);
                *(u32x4*)rowp = w; }
    }
};

struct EpiU {
    static constexpr bool PERM = true, AFTER_DRAIN = false;
    bf16_t* O; int ldc; float scale; int scale_from_pn; int mode; const float* rs; int rs_mode;
    __device__ __forceinline__ void operator()(const f32x4 (&acc)[2][2][4][2], const Unit& u, int wr, int wc, int fr, int fq) const {
        if (mode == 0) { EpiBf16S e{O, ldc, scale, scale_from_pn, rs, rs_mode}; e(acc, u, wr, wc, fr, fq); }
        else { EpiSwiGLU e{O, ldc, rs}; e(acc, u, wr, wc, fr, fq); }
    }
};
template <class Epi, class Sched, bool ALIGN_EPI, bool SP2, int KC>
__device__ __forceinline__ void gemm_phase(PG8_LAS unsigned char* lds, const Gemm g, const Sched& S, const Epi& E) {
    const int tid = threadIdx.x, wid = __builtin_amdgcn_readfirstlane(tid >> 6), lane = tid & 63, wr = wid >> 2, wc = wid & 3, fr = lane & 15, fq = lane >> 4;
    constexpr int K = KC, nt = K / BK;
    unsigned voffA[2], voffB[2];
#pragma unroll
    for (int i = 0; i < 2; ++i) { int R, C; stage_rc(tid * 16 + i * 8192, R, C); const int Rb = Epi::PERM ? ((R & ~31) + perm32(R & 31)) : R;
        voffA[i] = (unsigned)(R * K + C) * 2u; voffB[i] = (unsigned)(Rb * K + C) * 2u; }
    const size_t kstep = (size_t)(BK * 2);
    const size_t hstep = (size_t)HALF * K * 2;
    const size_t tstep = 2 * hstep;
    const unsigned ldsw = (unsigned)wid * 1024u;
    const int aoff = lds_byte(wr * 64 + fr, fq * 8), boff = lds_byte(wc * 32 + fr, fq * 8);
#define PG8_SA(b, h) (((b) * 2 + (h)) * HTB)
#define PG8_SB(b, h) ((4 + (b) * 2 + (h)) * HTB)
#define PG8_STAGE(bufoff, gbase, voff) do { _Pragma("unroll") for (int _i = 0; _i < 2; ++_i) \
        __builtin_amdgcn_global_load_lds((const unsigned*)((const char*)(gbase) + (voff)[_i]), (PG8_LAS unsigned*)(lds + (bufoff) + ldsw + _i * 8192), 16, 0, 0); } while (0)
#define PG8_LDA(dst, b, h) do { _Pragma("unroll") for (int m = 0; m < 4; ++m) _Pragma("unroll") for (int k = 0; k < 2; ++k) dst[m][k] = *(const PG8_LAS bf16x8*)(lds + PG8_SA(b, h) + aoff + m * 2048 + k * 1024); } while (0)
#define PG8_LDB(dst, b, h) do { _Pragma("unroll") for (int n = 0; n < 2; ++n) _Pragma("unroll") for (int k = 0; k < 2; ++k) dst[n][k] = *(const PG8_LAS bf16x8*)(lds + PG8_SB(b, h) + boff + n * 2048 + k * 1024); } while (0)
#define PG8_MMA(ai, bj, At, Bt) do { __builtin_amdgcn_s_setprio(1); _Pragma("unroll") for (int m = 0; m < 4; ++m) _Pragma("unroll") for (int n = 0; n < 2; ++n) _Pragma("unroll") for (int k = 0; k < 2; ++k) \
        acc[ai][bj][m][n] = __builtin_amdgcn_mfma_f32_16x16x32_bf16(Bt[n][k], At[m][k], acc[ai][bj][m][n], 0, 0, 0); __builtin_amdgcn_s_setprio(0); } while (0)
#define PG8_WAIT_V(n) asm volatile("s_waitcnt vmcnt(" #n ")" ::: "memory")
#define PG8_WAIT_L(n) asm volatile("s_waitcnt lgkmcnt(" #n ")" ::: "memory")
#define PG8_BAR __builtin_amdgcn_s_barrier()
#define PG8_SCHED __builtin_amdgcn_sched_barrier(0)
    Unit cur, nxt; int ui = 0;
    if (!S.next(0, cur)) return;
    f32x4 acc[2][2][4][2];
#pragma unroll
    for (int a = 0; a < 2; ++a)
#pragma unroll
        for (int b = 0; b < 2; ++b)
#pragma unroll
            for (int m = 0; m < 4; ++m)
#pragma unroll
                for (int n = 0; n < 2; ++n) acc[a][b][m][n] = (f32x4){0.f, 0.f, 0.f, 0.f};
    bf16x8 At[4][2], B0[2][2], B1[2][2];
    const char* cA = (const char*)g.A + (size_t)cur.pm * tstep; const char* cB = (const char*)g.Bt + (size_t)cur.pn * tstep;
    S.a_ready(cur);
    if constexpr (SP2) {
        PG8_STAGE(PG8_SB(0, 0), cB, voffB); PG8_STAGE(PG8_SB(0, 1), cB + hstep, voffB); PG8_STAGE(PG8_SA(0, 0), cA, voffA); PG8_STAGE(PG8_SA(0, 1), cA + hstep, voffA);
        if (wr == 1) PG8_BAR;
        PG8_WAIT_V(2); PG8_BAR;
        PG8_STAGE(PG8_SB(1, 0), cB + kstep, voffB); PG8_STAGE(PG8_SA(1, 0), cA + kstep, voffA); PG8_STAGE(PG8_SB(1, 1), cB + hstep + kstep, voffB);
        PG8_WAIT_V(6); PG8_BAR;
    } else {
        PG8_STAGE(PG8_SB(0, 0), cB, voffB); PG8_STAGE(PG8_SA(0, 0), cA, voffA); PG8_STAGE(PG8_SB(0, 1), cB + hstep, voffB); PG8_STAGE(PG8_SA(0, 1), cA + hstep, voffA);
        if (wr == 1) PG8_BAR;
        PG8_WAIT_V(4); PG8_BAR;
        PG8_STAGE(PG8_SB(1, 0), cB + kstep, voffB); PG8_STAGE(PG8_SA(1, 0), cA + kstep, voffA); PG8_STAGE(PG8_SB(1, 1), cB + hstep + kstep, voffB);
        PG8_WAIT_V(6); PG8_BAR;
    }
    for (;;) {
        const bool has_next = S.next(ui + 1, nxt);
        const char* nA = has_next ? (const char*)g.A + (size_t)nxt.pm * tstep : cA; const char* nB = has_next ? (const char*)g.Bt + (size_t)nxt.pn * tstep : cB;
        for (int t = 0; t < nt; t += 2) {
            const bool last = (t == nt - 2);
            const char* a1 = cA + (size_t)(t + 1) * kstep;
            const char* a2 = last ? nA : cA + (size_t)(t + 2) * kstep; const char* b2 = last ? nB : cB + (size_t)(t + 2) * kstep;
            const char* a3 = a2 + kstep; const char* b3 = b2 + kstep;
            if (last && has_next) S.a_ready(nxt);
            if constexpr (SP2) {
            PG8_LDB(B0, 0, 0); PG8_LDB(B1, 0, 1); PG8_SCHED; PG8_LDA(At, 0, 0); PG8_STAGE(PG8_SA(1, 1), a1 + hstep, voffA);
            PG8_WAIT_V(8); PG8_WAIT_L(0); PG8_BAR; PG8_MMA(0, 0, At, B0); PG8_MMA(0, 1, At, B1); PG8_BAR; PG8_SCHED;
            PG8_LDA(At, 0, 1); PG8_STAGE(PG8_SB(0, 0), b2, voffB); PG8_STAGE(PG8_SB(0, 1), b2 + hstep, voffB); PG8_STAGE(PG8_SA(0, 0), a2, voffA);
            PG8_WAIT_V(8); PG8_WAIT_L(0); PG8_BAR; PG8_MMA(1, 0, At, B0); PG8_MMA(1, 1, At, B1); PG8_BAR; PG8_SCHED;
            PG8_LDB(B0, 1, 0); PG8_LDB(B1, 1, 1); PG8_SCHED; PG8_LDA(At, 1, 0); PG8_STAGE(PG8_SA(0, 1), a2 + hstep, voffA);
            PG8_WAIT_V(8); PG8_WAIT_L(0); PG8_BAR; PG8_MMA(0, 0, At, B0); PG8_MMA(0, 1, At, B1); PG8_BAR; PG8_SCHED;
            PG8_LDA(At, 1, 1); PG8_STAGE(PG8_SB(1, 0), b3, voffB); PG8_STAGE(PG8_SB(1, 1), b3 + hstep, voffB); PG8_STAGE(PG8_SA(1, 0), a3, voffA);
            PG8_WAIT_V(8); PG8_WAIT_L(0); PG8_BAR; PG8_MMA(1, 0, At, B0); PG8_MMA(1, 1, At, B1); PG8_BAR; PG8_SCHED;
            } else {
            PG8_LDB(B0, 0, 0); PG8_SCHED; PG8_LDA(At, 0, 0); PG8_STAGE(PG8_SA(1, 1), a1 + hstep, voffA);
            PG8_WAIT_L(8); PG8_BAR; PG8_WAIT_L(0); PG8_MMA(0, 0, At, B0); PG8_BAR; PG8_SCHED;
            PG8_LDB(B1, 0, 1); PG8_STAGE(PG8_SB(0, 0), b2, voffB);
            PG8_BAR; PG8_WAIT_L(0); PG8_MMA(0, 1, At, B1); PG8_BAR;
            PG8_LDA(At, 0, 1); PG8_STAGE(PG8_SA(0, 0), a2, voffA);
            PG8_BAR; PG8_WAIT_L(0); PG8_MMA(1, 0, At, B0); PG8_BAR; PG8_SCHED;
            PG8_STAGE(PG8_SB(0, 1), b2 + hstep, voffB);
            PG8_WAIT_V(6); PG8_BAR; PG8_MMA(1, 1, At, B1); PG8_BAR;
            PG8_LDB(B0, 1, 0); PG8_SCHED; PG8_LDA(At, 1, 0); PG8_STAGE(PG8_SA(0, 1), a2 + hstep, voffA);
            PG8_WAIT_L(8); PG8_BAR; PG8_WAIT_L(0); PG8_MMA(0, 0, At, B0); PG8_BAR; PG8_SCHED;
            PG8_LDB(B1, 1, 1); PG8_STAGE(PG8_SB(1, 0), b3, voffB);
            PG8_BAR; PG8_WAIT_L(0); PG8_MMA(0, 1, At, B1); PG8_BAR;
            PG8_LDA(At, 1, 1); PG8_STAGE(PG8_SA(1, 0), a3, voffA);
            PG8_BAR; PG8_WAIT_L(0); PG8_MMA(1, 0, At, B0); PG8_BAR; PG8_SCHED;
            PG8_STAGE(PG8_SB(1, 1), b3 + hstep, voffB);
            PG8_WAIT_V(6); PG8_BAR; PG8_MMA(1, 1, At, B1); PG8_BAR;
            }
        }
        if constexpr (ALIGN_EPI) { if (wr == 0) PG8_BAR; }
        if constexpr (!Epi::AFTER_DRAIN) { E(acc, cur, wr, wc, fr, fq); S.done(cur); }
        if (!has_next) break;
#pragma unroll
        for (int a = 0; a < 2; ++a)
#pragma unroll
            for (int b = 0; b < 2; ++b)
#pragma unroll
                for (int m = 0; m < 4; ++m)
#pragma unroll
                    for (int n = 0; n < 2; ++n) acc[a][b][m][n] = (f32x4){0.f, 0.f, 0.f, 0.f};
        cur = nxt; cA = nA; cB = nB; ++ui;
        if constexpr (ALIGN_EPI) { if (wr == 1) PG8_BAR; }
    }
    PG8_WAIT_V(0);
    if constexpr (!ALIGN_EPI) { if (wr == 0) PG8_BAR; }
    PG8_BAR;
    if constexpr (Epi::AFTER_DRAIN) { E.fused(acc, cur, wr, wc, fr, fq, lds, wid, lane); S.done(cur); }
#undef PG8_SA
#undef PG8_SB
#undef PG8_STAGE
#undef PG8_LDA
#undef PG8_LDB
#undef PG8_MMA
#undef PG8_WAIT_V
#undef PG8_WAIT_L
#undef PG8_BAR
#undef PG8_SCHED
}
}

#define LAS __attribute__((address_space(3)))
typedef unsigned short bf16;
typedef float f32x4 __attribute__((ext_vector_type(4)));
typedef float f32x16 __attribute__((ext_vector_type(16)));
typedef unsigned v4u __attribute__((ext_vector_type(4)));
typedef unsigned v2u __attribute__((ext_vector_type(2)));
typedef short bf16x8 __attribute__((ext_vector_type(8)));

constexpr int NB = 2, SEQ = 16384, M = NB * SEQ, D = 1024, FF = 2816, RW = 768, MW = 256, NMEM = 256, NH = 12, PROJ_LD = 2 * RW + MW;
constexpr int TC = 128, NCHUNK = SEQ / TC, NBLK = 12;
constexpr float EPS = 1e-6f, QSCALE = 0.18033688f  , LOG2E = 1.44269504f;
#ifndef DUP_MISC
#define DUP_MISC 1
#endif
#ifndef ROWS_R
#define ROWS_R 4
#endif
#ifndef DUP_PRO
#define DUP_PRO DUP_MISC
#endif
#ifndef DUP_SA
#define DUP_SA DUP_MISC
#endif
#ifndef DUP_SC
#define DUP_SC DUP_MISC
#endif
#ifndef DUP_MA
#define DUP_MA DUP_MISC
#endif
#ifndef DUP_SB
#define DUP_SB DUP_MISC
#endif
#ifndef DUP_SYNC
#define DUP_SYNC 1
#endif
#ifndef DUP_GEMM
#define DUP_GEMM 1
#endif
constexpr int NWAVES = 8, NTHR = 512;
constexpr int LDS_BYTES = 131072 + 1024;

constexpr size_t MiB = 1u << 20;
constexpr size_t SZ_WGU = (size_t)2 * FF * D * 2, SZ_WD = (size_t)D * FF * 2;
constexpr size_t WS_WGU = 1 * MiB, WS_WD = WS_WGU + 4 * SZ_WGU, WS_WAIN = WS_WD + 4 * SZ_WD, WS_WBIN = WS_WAIN + (size_t)PROJ_LD * D * 2,
                 WS_WKV = WS_WBIN + (size_t)D * D * 2, WS_WMIX = WS_WKV + (size_t)2 * RW * D * 2, WS_Z = WS_WMIX + (size_t)2 * D * D * 2, WS_WEND = WS_Z + (size_t)2048 * D * 2;
static_assert(WS_WEND <= 88 * MiB, "weights region");
constexpr size_t WS_XN = 88 * MiB;
constexpr size_t WS_Y = 152 * MiB;
constexpr size_t WS_H = 216 * MiB;
constexpr size_t WS_KV = 392 * MiB;
constexpr size_t WS_CZ = 488 * MiB;
constexpr size_t WS_AGG = 496 * MiB;
constexpr size_t WS_GWT = 500 * MiB;
constexpr size_t WS_RS = 504 * MiB;
constexpr size_t WS_END = 512 * MiB;

__device__ __forceinline__ float bflo(unsigned w) { return __uint_as_float(w << 16); }
__device__ __forceinline__ float bfhi(unsigned w) { return __uint_as_float(w & 0xffff0000u); }
__device__ __forceinline__ float bf2f(bf16 v) { return __uint_as_float(((unsigned)v) << 16); }
__device__ __forceinline__ bf16 f2bf(float f) { return (bf16)(pk2(f, 0.f) & 0xffffu); }
__device__ __forceinline__ float wave_sum(float v) {
#pragma unroll
    for (int o = 1; o < 64; o <<= 1) v += __shfl_xor(v, o);
    return v;
}
#define LDS_WAIT() asm volatile("s_waitcnt lgkmcnt(0)" ::: "memory")
#define MFMA32(a, b, c) __builtin_amdgcn_mfma_f32_32x32x16_bf16((a), (b), (c), 0, 0, 0)

__device__ __forceinline__ void tr_item(const float* W, int K, int N, bf16* WT, int mode, int row_off, LAS float* scr, int item, int lane, const float* gk) {
    const int nblk = N / 32, kb = item / nblk, nb = item % nblk, k0 = 64 * kb, n0 = 32 * nb;
#pragma unroll
    for (int i = 0; i < 8; ++i) { const int kk = 8 * i + (lane >> 3); const float gsc = gk ? gk[k0 + kk] : 1.0f;
        const f32x4 v = *(const f32x4*)(W + (size_t)(k0 + kk) * N + n0 + 4 * (lane & 7)) * gsc;
        LAS float* d = scr + kk * 33 + 4 * (lane & 7); d[0] = v.x; d[1] = v.y; d[2] = v.z; d[3] = v.w; }
    LDS_WAIT(); asm volatile("" ::: "memory");
    const int rb = (mode == 0) ? (row_off + n0) : (256 * (n0 >> 7) + (n0 & 127) + (mode == 2 ? 128 : 0));
    const int c = lane & 7;
#pragma unroll
    for (int j = 0; j < 4; ++j) { const int n = (lane >> 3) + 8 * j; const LAS float* s = scr + (8 * c) * 33 + n;
        v4u o; o.x = pk2(s[0 * 33], s[1 * 33]); o.y = pk2(s[2 * 33], s[3 * 33]); o.z = pk2(s[4 * 33], s[5 * 33]); o.w = pk2(s[6 * 33], s[7 * 33]);
        *(v4u*)(WT + (size_t)(rb + n) * K + k0 + 8 * c) = o; }
    LDS_WAIT(); asm volatile("" ::: "memory");
}

template <int R, bool XIB, bool XOB>
__device__ __forceinline__ void row_jobs(const void* xin, const bf16* F, const float* gf, float coef, void* xout, const float* g1, bf16* N1, const float* g2, bf16* N2, int m0, int ms, int lane, float* rsout = nullptr) {
    f32x4 v[R][4];
    if (XIB) {
        v2u xw[R][4];
#pragma unroll
        for (int k = 0; k < R; ++k)
#pragma unroll
            for (int j = 0; j < 4; ++j) xw[k][j] = *(const v2u*)((const bf16*)xin + (size_t)(m0 + k * ms) * D + 4 * lane + 256 * j);
#pragma unroll
        for (int k = 0; k < R; ++k)
#pragma unroll
            for (int j = 0; j < 4; ++j) v[k][j] = (f32x4){bflo(xw[k][j].x), bfhi(xw[k][j].x), bflo(xw[k][j].y), bfhi(xw[k][j].y)};
    } else {
#pragma unroll
        for (int k = 0; k < R; ++k)
#pragma unroll
            for (int j = 0; j < 4; ++j) v[k][j] = *(const f32x4*)((const float*)xin + (size_t)(m0 + k * ms) * D + 4 * lane + 256 * j);
    }
    if (F) {
        v2u fw[R][4];
#pragma unroll
        for (int k = 0; k < R; ++k)
#pragma unroll
            for (int j = 0; j < 4; ++j) fw[k][j] = *(const v2u*)(F + (size_t)(m0 + k * ms) * D + 4 * lane + 256 * j);
        f32x4 gfv[4];
#pragma unroll
        for (int j = 0; j < 4; ++j) gfv[j] = *(const f32x4*)(gf + 4 * lane + 256 * j);
#pragma unroll
        for (int k = 0; k < R; ++k) {
            f32x4 f[4]; float ss = 0.f;
#pragma unroll
            for (int j = 0; j < 4; ++j) { f[j] = (f32x4){bflo(fw[k][j].x), bfhi(fw[k][j].x), bflo(fw[k][j].y), bfhi(fw[k][j].y)};
                ss += (f[j].x * f[j].x + f[j].y * f[j].y) + (f[j].z * f[j].z + f[j].w * f[j].w); }
            ss = wave_sum(ss);
            const float rf = rsqrtf(ss * (1.0f / D) + EPS) * coef;
#pragma unroll
            for (int j = 0; j < 4; ++j) v[k][j] = v[k][j] + f[j] * gfv[j] * rf;
        }
    }
    if (xout) {
#pragma unroll
        for (int k = 0; k < R; ++k)
#pragma unroll
            for (int j = 0; j < 4; ++j) {
                if (XOB) { v2u w; w.x = pk2(v[k][j].x, v[k][j].y); w.y = pk2(v[k][j].z, v[k][j].w); *(v2u*)((bf16*)xout + (size_t)(m0 + k * ms) * D + 4 * lane + 256 * j) = w; }
                else *(f32x4*)((float*)xout + (size_t)(m0 + k * ms) * D + 4 * lane + 256 * j) = v[k][j]; }
    }
    if (N1 || N2 || rsout) {
        float r[R];
#pragma unroll
        for (int k = 0; k < R; ++k) { float s2 = 0.f;
#pragma unroll
            for (int j = 0; j < 4; ++j) s2 += (v[k][j].x * v[k][j].x + v[k][j].y * v[k][j].y) + (v[k][j].z * v[k][j].z + v[k][j].w * v[k][j].w);
            r[k] = rsqrtf(wave_sum(s2) * (1.0f / D) + EPS); if (rsout && lane == 0) rsout[m0 + k * ms] = r[k]; }
        if (N1) {
#pragma unroll
            for (int j = 0; j < 4; ++j) { const f32x4 g = *(const f32x4*)(g1 + 4 * lane + 256 * j);
#pragma unroll
                for (int k = 0; k < R; ++k) { const f32x4 o = v[k][j] * g * r[k]; v2u w; w.x = pk2(o.x, o.y); w.y = pk2(o.z, o.w); *(v2u*)(N1 + (size_t)(m0 + k * ms) * D + 4 * lane + 256 * j) = w; } }
        }
        if (N2) {
#pragma unroll
            for (int j = 0; j < 4; ++j) { const f32x4 g = *(const f32x4*)(g2 + 4 * lane + 256 * j);
#pragma unroll
                for (int k = 0; k < R; ++k) { const f32x4 o = v[k][j] * g * r[k]; v2u w; w.x = pk2(o.x, o.y); w.y = pk2(o.z, o.w); *(v2u*)(N2 + (size_t)(m0 + k * ms) * D + 4 * lane + 256 * j) = w; } }
        }
    }
}
__device__ __forceinline__ void row_job(const float* xr, const bf16* fr, const float* gf, float coef, float* xo, const float* g1, bf16* n1, const float* g2, bf16* n2, int lane) {
    row_jobs<1, false, false>(xr, fr, gf, coef, xo, g1, n1, g2, n2, 0, 0, lane);
}

__device__ __forceinline__ int kappa(int rho) { return 16 * ((rho >> 2) & 1) + 4 * (rho >> 3) + (rho & 3); }
__device__ __forceinline__ bf16x8 pack8(const f32x16& w, int s) {
    v4u p; p.x = pk2(w[8 * s + 0], w[8 * s + 1]); p.y = pk2(w[8 * s + 2], w[8 * s + 3]); p.z = pk2(w[8 * s + 4], w[8 * s + 5]); p.w = pk2(w[8 * s + 6], w[8 * s + 7]);
    return __builtin_bit_cast(bf16x8, p);
}
__device__ __forceinline__ void store_o(bf16* yrow, const f32x16& o0, const f32x16& o1, float sc, int hh) {
#pragma unroll
    for (int g = 0; g < 4; ++g) {
        v2u a; a.x = pk2(o0[4 * g] * sc, o0[4 * g + 1] * sc); a.y = pk2(o0[4 * g + 2] * sc, o0[4 * g + 3] * sc); *(v2u*)(yrow + 8 * g + 4 * hh) = a;
        v2u b; b.x = pk2(o1[4 * g] * sc, o1[4 * g + 1] * sc); b.y = pk2(o1[4 * g + 2] * sc, o1[4 * g + 3] * sc); *(v2u*)(yrow + 32 + 8 * g + 4 * hh) = b;
    }
}

constexpr int MK_LD = 72, MV_LD = 264;
__device__ __forceinline__ void mem_attn_phase(LAS unsigned char* lds, const bf16* Q, int ldq, int qcol, const bf16* CZ, int l, bf16* Y, int bx, int G, int tid) {
    const int np = (G >= 8) ? 8 : 1, pair = bx % np, j = bx / np, nper = (G + np - 1 - pair) / np;
    LAS bf16* Ks = (LAS bf16*)lds; LAS bf16* Vs = Ks + 256 * MK_LD;
    int tid_o = tid; asm volatile("" : "+v"(tid_o)); tid_o &= 511;
    const int lane = tid_o & 63, wave = tid_o >> 6, r = lane & 31, hh = lane >> 5;
    for (int pr = pair; pr < 8; pr += np) {
        const int b = pr >> 2, h = pr & 3;
        __syncthreads();
#pragma unroll
        for (int it = 0; it < 4; ++it) { const int idx = tid_o + NTHR * it;
            { const int key = idx >> 3, ck = idx & 7; *(LAS v4u*)(Ks + key * MK_LD + 8 * ck) = *(const v4u*)(CZ + (size_t)(l * 512 + b * 256 + key) * 2048 + 1024 + l * 512 + h * 64 + 8 * ck); }
            { const int d = idx >> 5, ck = idx & 31; *(LAS v4u*)(Vs + d * MV_LD + 8 * ck) = *(const v4u*)(CZ + (size_t)(1024 + l * 512 + 256 + h * 64 + d) * 2048 + l * 512 + b * 256 + 8 * ck); } }
        __syncthreads();
        for (int t = j * NWAVES + wave; t < SEQ / 32; t += nper * NWAVES) {
            const size_t tok0 = (size_t)b * SEQ + t * 32;
            bf16x8 qf[4];
#pragma unroll
            for (int s = 0; s < 4; ++s) qf[s] = *(const bf16x8*)(Q + (tok0 + r) * ldq + qcol + h * 64 + 16 * s + 8 * hh);
            float mrun = -1e30f, lsum = 0.f;
            f32x16 o0, o1;
#pragma unroll
            for (int i = 0; i < 16; ++i) { o0[i] = 0.f; o1[i] = 0.f; }
#pragma unroll 2
            for (int kt = 0; kt < 8; ++kt) {
                bf16x8 kf[4], vf[2][2];
#pragma unroll
                for (int s = 0; s < 4; ++s) kf[s] = *(const LAS bf16x8*)(Ks + (kt * 32 + kappa(r)) * MK_LD + 16 * s + 8 * hh);
#pragma unroll
                for (int dt = 0; dt < 2; ++dt)
#pragma unroll
                    for (int s = 0; s < 2; ++s) vf[dt][s] = *(const LAS bf16x8*)(Vs + (dt * 32 + r) * MV_LD + kt * 32 + 16 * hh + 8 * s);
                f32x16 st;
#pragma unroll
                for (int i = 0; i < 16; ++i) st[i] = 0.f;
#pragma unroll
                for (int s = 0; s < 4; ++s) st = MFMA32(kf[s], qf[s], st);
                float mx = st[0];
#pragma unroll
                for (int i = 1; i < 16; ++i) mx = fmaxf(mx, st[i]);
                mx = fmaxf(mx, __shfl_xor(mx, 32));
                const float mnew = fmaxf(mrun, mx), alpha = __builtin_amdgcn_exp2f(mrun - mnew);
                mrun = mnew;
                float ps = 0.f;
#pragma unroll
                for (int i = 0; i < 16; ++i) { st[i] = __builtin_amdgcn_exp2f(st[i] - mnew); ps += st[i]; }
                lsum = lsum * alpha + ps;
#pragma unroll
                for (int i = 0; i < 16; ++i) { o0[i] *= alpha; o1[i] *= alpha; }
                const bf16x8 p0 = pack8(st, 0), p1 = pack8(st, 1);
                o0 = MFMA32(vf[0][0], p0, o0); o0 = MFMA32(vf[0][1], p1, o0);
                o1 = MFMA32(vf[1][0], p0, o1); o1 = MFMA32(vf[1][1], p1, o1);
            }
            const float tot = lsum + __shfl_xor(lsum, 32);
            store_o(Y + (tok0 + r) * D + RW + h * 64, o0, o1, 1.0f / tot, hh);
        }
    }
    __syncthreads();
}

__device__ __forceinline__ void sb_attn_unit(const bf16* Q, const bf16* KB, const bf16* VT, bf16* Y, int unit, int lane) {
    const int qt = unit & 511, bh = unit >> 9, h = bh % NH, b = bh / NH, r = lane & 31, hh = lane >> 5;
    const size_t tok0 = (size_t)b * SEQ + qt * 32;
    bf16x8 qf[4];
#pragma unroll
    for (int s = 0; s < 4; ++s) qf[s] = *(const bf16x8*)(Q + (tok0 + r) * D + h * 64 + 16 * s + 8 * hh);
    const bf16* Kb = KB + ((size_t)b * SEQ + kappa(r)) * RW + h * 64 + 8 * hh;
    const bf16* Vb = VT + (size_t)(h * 64 + r) * M + (size_t)b * SEQ + 16 * hh;
    float rest = 0.f;
    f32x16 o0, o1;
#pragma unroll
    for (int i = 0; i < 16; ++i) { o0[i] = 0.f; o1[i] = 0.f; }
    bf16x8 kf[4], vf[2][2];
#pragma unroll
    for (int s = 0; s < 4; ++s) kf[s] = *(const bf16x8*)(Kb + (size_t)qt * 32 * RW + 16 * s);
#pragma unroll
    for (int dt = 0; dt < 2; ++dt)
#pragma unroll
        for (int s = 0; s < 2; ++s) vf[dt][s] = *(const bf16x8*)(Vb + (size_t)dt * 32 * M + qt * 32 + 8 * s);
    for (int kt = qt; kt >= 0; --kt) {
        bf16x8 kn[4], vn[2][2];
        const int ktn = kt > 0 ? kt - 1 : 0;
#pragma unroll
        for (int s = 0; s < 4; ++s) kn[s] = *(const bf16x8*)(Kb + (size_t)ktn * 32 * RW + 16 * s);
#pragma unroll
        for (int dt = 0; dt < 2; ++dt)
#pragma unroll
            for (int s = 0; s < 2; ++s) vn[dt][s] = *(const bf16x8*)(Vb + (size_t)dt * 32 * M + ktn * 32 + 8 * s);
        f32x16 z;
#pragma unroll
        for (int i = 0; i < 16; ++i) z[i] = 0.f;
#pragma unroll
        for (int s = 0; s < 4; ++s) z = MFMA32(kf[s], qf[s], z);
        float t[16];
#pragma unroll
        for (int i = 0; i < 16; ++i) t[i] = __builtin_amdgcn_exp2f(fminf(z[i], 30.0f));
        if (kt == qt) {
#pragma unroll
            for (int i = 0; i < 16; ++i) t[i] = (16 * hh + i < r) ? t[i] : 0.f;
        }
        float lg[4]; f32x16 w;
#pragma unroll
        for (int g = 0; g < 4; ++g) {
            const float u0 = 1.f + t[4 * g], u1 = 1.f + t[4 * g + 1], u2 = 1.f + t[4 * g + 2], u3 = 1.f + t[4 * g + 3];
            const float p1 = u0, p2 = p1 * u1, p3 = p2 * u2, G = p3 * u3;
            lg[g] = __builtin_amdgcn_logf(G);
            w[4 * g] = t[4 * g]; w[4 * g + 1] = t[4 * g + 1] * p1; w[4 * g + 2] = t[4 * g + 2] * p2; w[4 * g + 3] = t[4 * g + 3] * p3;
        }
        const float LT = (lg[0] + lg[1]) + (lg[2] + lg[3]);
        const float OT = __shfl_xor(LT, 32);
        float sg = rest - (hh == 0 ? OT : 0.f);
#pragma unroll
        for (int g = 3; g >= 0; --g) { sg -= lg[g]; const float e = __builtin_amdgcn_exp2f(sg);
            w[4 * g] *= e; w[4 * g + 1] *= e; w[4 * g + 2] *= e; w[4 * g + 3] *= e; }
        rest = rest - LT - OT;
        const bf16x8 p0 = pack8(w, 0), p1 = pack8(w, 1);
        o0 = MFMA32(vf[0][0], p0, o0); o0 = MFMA32(vf[0][1], p1, o0);
        o1 = MFMA32(vf[1][0], p0, o1); o1 = MFMA32(vf[1][1], p1, o1);
        if (__all(rest < -32.0f)) break;
#pragma unroll
        for (int s = 0; s < 4; ++s) kf[s] = kn[s];
        vf[0][0] = vn[0][0]; vf[0][1] = vn[0][1]; vf[1][0] = vn[1][0]; vf[1][1] = vn[1][1];
    }
    store_o(Y + (tok0 + r) * D + h * 64, o0, o1, 1.0f, hh);
}

__device__ __forceinline__ void scan_a_unit(LAS unsigned char* lds, const bf16* PROJ, const float* conv_w, const float* conv_b, const bf16* GWT, const float* gate_b,
                                            const float* lam, bf16* HL, bf16* PP, float* AGG, int unit, int tid) {
    const int n = unit % NBLK, c = (unit / NBLK) % NCHUNK, b = unit / (NBLK * NCHUNK);
    LAS float* xr = (LAS float*)lds;
    LAS float* xc = (LAS float*)(lds + 34816);
    LAS bf16* xcb = (LAS bf16*)(lds + 34816 + 32768);
    LAS bf16* wt = xcb + 128 * 72;
    LAS float* part = (LAS float*)(wt + 128 * 72);
    const int t0 = c * TC;
    const size_t tokbase = (size_t)b * SEQ + t0;
    { unsigned xw[9]; v4u gw_[2];
#pragma unroll
      for (int it = 0; it < 9; ++it) { const int idx = tid + NTHR * it, row = idx >> 5, cp = idx & 31, t = t0 - 3 + row; xw[it] = 0u;
        if (idx < 131 * 32 && t >= 0) xw[it] = *(const unsigned*)(PROJ + ((size_t)b * SEQ + t) * PROJ_LD + n * 64 + 2 * cp); }
#pragma unroll
      for (int it = 0; it < 2; ++it) { const int idx = tid + NTHR * it, row = idx >> 3, ck = idx & 7; gw_[it] = *(const v4u*)(GWT + (size_t)n * 8192 + row * 64 + 8 * ck); }
#pragma unroll
      for (int it = 0; it < 9; ++it) { const int idx = tid + NTHR * it, row = idx >> 5, cp = idx & 31;
        if (idx < 131 * 32) { xr[row * 64 + 2 * cp] = bflo(xw[it]); xr[row * 64 + 2 * cp + 1] = bfhi(xw[it]); } }
#pragma unroll
      for (int it = 0; it < 2; ++it) { const int idx = tid + NTHR * it, row = idx >> 3, ck = idx & 7; *(LAS v4u*)(wt + row * 72 + 8 * ck) = gw_[it]; } }
    __syncthreads();
    { const int ch = tid & 63, sub = tid >> 6, col = n * 64 + ch;
      const float w0 = conv_w[col], w1 = conv_w[RW + col], w2 = conv_w[2 * RW + col], w3 = conv_w[3 * RW + col], cb = conv_b[col];
#pragma unroll
      for (int i = 0; i < 16; ++i) { const int t = sub * 16 + i;
        const float v = cb + w0 * xr[t * 64 + ch] + w1 * xr[(t + 1) * 64 + ch] + w2 * xr[(t + 2) * 64 + ch] + w3 * xr[(t + 3) * 64 + ch];
        xc[t * 64 + ch] = v; xcb[t * 72 + ch] = f2bf(v); } }
    __syncthreads();
    const int wv = tid >> 6, lane = tid & 63, c32 = lane & 31, hh = lane >> 5, tg = wv >> 1, ch = 32 * (wv & 1) + c32, sub = 2 * tg + hh, col = n * 64 + ch;
    f32x16 ar, ai;
    { const float br = gate_b[col], bi = gate_b[RW + col];
#pragma unroll
      for (int i = 0; i < 16; ++i) { ar[i] = br; ai[i] = bi; } }
#pragma unroll
    for (int s = 0; s < 4; ++s) {
        const bf16x8 af = *(const LAS bf16x8*)(xcb + (32 * tg + kappa(c32)) * 72 + 16 * s + 8 * hh);
        const bf16x8 br_ = *(const LAS bf16x8*)(wt + ch * 72 + 16 * s + 8 * hh), bi_ = *(const LAS bf16x8*)(wt + (64 + ch) * 72 + 16 * s + 8 * hh);
        ar = MFMA32(af, br_, ar); ai = MFMA32(af, bi_, ai);
    }
    const float c8 = -8.0f * LOG2E * log1pf(expf(-lam[col]));
    float hl[16], pp[16]; float hcur = 0.f, pcur = 1.f;
#pragma unroll
    for (int i = 0; i < 16; ++i) {
        const float rg = __builtin_amdgcn_rcpf(1.0f + __builtin_amdgcn_exp2f(-LOG2E * ar[i])), ig = __builtin_amdgcn_rcpf(1.0f + __builtin_amdgcn_exp2f(-LOG2E * ai[i]));
        const float a = __builtin_amdgcn_exp2f(c8 * rg), mult = __builtin_amdgcn_sqrtf(fmaxf(1.0f - a * a, 0.0f));
        hcur = a * hcur + mult * ig * xc[(sub * 16 + i) * 64 + ch]; pcur *= a; hl[i] = hcur; pp[i] = pcur; }
    part[(sub * 64 + ch) * 2] = pcur; part[(sub * 64 + ch) * 2 + 1] = hcur;
    __syncthreads();
    float hc = 0.f, pc = 1.f;
    for (int s = 0; s < sub; ++s) { const float ps = part[(s * 64 + ch) * 2], hs = part[(s * 64 + ch) * 2 + 1]; hc = ps * hc + hs; pc *= ps; }
#pragma unroll
    for (int i = 0; i < 16; ++i) { hl[i] += pp[i] * hc; pp[i] *= pc; }
#pragma unroll
    for (int i = 0; i < 16; ++i) { const size_t o = (tokbase + sub * 16 + i) * RW + col; HL[o] = f2bf(hl[i]); PP[o] = f2bf(pp[i]); }
    if (sub == 7) { float* ag = AGG + ((size_t)(b * NCHUNK + c) * RW + col) * 2; ag[0] = pp[15]; ag[1] = hl[15]; }
    __syncthreads();
}
__device__ __forceinline__ void scan_c_unit(LAS unsigned char* lds, const bf16* PROJ, const bf16* HL, const bf16* PP, const float* AGG, bf16* Y, int unit, int tid) {
    const int n = unit % NBLK, c = (unit / NBLK) % NCHUNK, b = unit / (NBLK * NCHUNK);
    LAS float* part = (LAS float*)lds;
    LAS float* carryL = part + 1024;
    const int ch = tid & 63, sub = tid >> 6, col = n * 64 + ch;
    const size_t tokbase = (size_t)b * SEQ + c * TC;
    { mk_f32x2_t ag[16];
#pragma unroll
      for (int k = 0; k < 16; ++k) ag[k] = *(const mk_f32x2_t*)(AGG + ((size_t)(b * NCHUNK + sub * 16 + k) * RW + col) * 2);
      float pq = 1.f, hq = 0.f;
#pragma unroll
      for (int k = 0; k < 16; ++k) { const bool use = (sub * 16 + k) < c; const float pa = use ? ag[k].x : 1.f, ha = use ? ag[k].y : 0.f; hq = pa * hq + ha; pq *= pa; }
      part[(sub * 64 + ch) * 2] = pq; part[(sub * 64 + ch) * 2 + 1] = hq; }
    __syncthreads();
    if (tid < 64) { float carry = 0.f;
#pragma unroll
        for (int s = 0; s < 8; ++s) carry = part[(s * 64 + tid) * 2] * carry + part[(s * 64 + tid) * 2 + 1];
        carryL[tid] = carry; }
    __syncthreads();
#pragma unroll
    for (int it = 0; it < 2; ++it) { const int item = tid + NTHR * it, tok = item >> 3, ck = item & 7;
        const size_t row = tokbase + tok;
        const v4u hv = *(const v4u*)(HL + row * RW + n * 64 + 8 * ck), pv = *(const v4u*)(PP + row * RW + n * 64 + 8 * ck), gv = *(const v4u*)(PROJ + row * PROJ_LD + RW + n * 64 + 8 * ck);
        float y[8];
#pragma unroll
        for (int q = 0; q < 4; ++q) {
#pragma unroll
            for (int hf = 0; hf < 2; ++hf) {
                const float hl_ = hf ? bfhi(hv[q]) : bflo(hv[q]), pp_ = hf ? bfhi(pv[q]) : bflo(pv[q]), xg = hf ? bfhi(gv[q]) : bflo(gv[q]);
                const float hfull = hl_ + pp_ * carryL[8 * ck + 2 * q + hf];
                const float uu = 0.7978845608f * (xg + 0.044715f * xg * xg * xg);
                y[2 * q + hf] = xg * __builtin_amdgcn_rcpf(1.0f + __builtin_amdgcn_exp2f(-2.0f * LOG2E * uu)) * hfull; } }
        v4u o; o.x = pk2(y[0], y[1]); o.y = pk2(y[2], y[3]); o.z = pk2(y[4], y[5]); o.w = pk2(y[6], y[7]);
        *(v4u*)(Y + row * D + n * 64 + 8 * ck) = o; }
    __syncthreads();
}

#define XB_TMO      128
#define XB_XCNT(j)  (256  + 64 * (j))
#define XB_XSUB(j)  (1280 + 64 * (j))
#define XB_XGEN(j)  (2304 + 64 * (j))
#define XB_TOP      3328
#define XB_TOPGEN   3392
#define XCD_BAR_WORDS 3456
#define XB_SPIN_CAP (1u << 18)

__device__ __forceinline__ unsigned xb_ld(unsigned* p)              { return __hip_atomic_load(p, __ATOMIC_RELAXED, __HIP_MEMORY_SCOPE_AGENT); }
__device__ __forceinline__ unsigned xb_add(unsigned* p, unsigned v) { return __hip_atomic_fetch_add(p, v, __ATOMIC_RELAXED, __HIP_MEMORY_SCOPE_AGENT); }
__device__ __forceinline__ unsigned xb_xcc_id() { return (unsigned)__builtin_amdgcn_s_getreg((3 << 11) | 20) & 0xFu; }
#define XB_SPIN(cond, bar) do { unsigned _sp = 0; while (cond) { __builtin_amdgcn_s_sleep(1); \
    if ((++_sp & 255u) == 0u) { if (xb_ld(&(bar)[XB_TMO])) break; if (_sp > XB_SPIN_CAP) { atomicAdd(&(bar)[XB_TMO], 1u); break; } } } } while (0)

struct XcdBarrier {
    unsigned* bar; unsigned x;
    volatile LAS unsigned* st;
};

__device__ __forceinline__ XcdBarrier xcd_barrier_post(unsigned* bar, volatile LAS unsigned* st) {
    XcdBarrier b; b.bar = bar; b.x = xb_xcc_id(); b.st = st;
    if (threadIdx.x == 0) (void)xb_add(&bar[XB_XCNT(b.x)], 1u);
    return b;
}
__device__ __forceinline__ void xcd_barrier_complete(unsigned* bar, unsigned x, unsigned& nloc, unsigned& nx) {
    const unsigned G = gridDim.x * gridDim.y * gridDim.z;
    unsigned sum, cnt, mine, sp = 0u;
    for (;;) {
        sum = 0u; cnt = 0u; mine = 0u;
#pragma unroll
        for (unsigned j = 0; j < 16; ++j) { const unsigned c = xb_ld(&bar[XB_XCNT(j)]); sum += c; cnt += (c > 0u) ? 1u : 0u; mine = (j == x) ? c : mine; }
        if (sum == G) break;
        __builtin_amdgcn_s_sleep(1);
        if ((++sp & 255u) == 0u) { if (xb_ld(&bar[XB_TMO])) break; if (sp > XB_SPIN_CAP) { atomicAdd(&bar[XB_TMO], 1u); break; } }
    }
    nloc = mine > 0u ? mine : 1u; nx = cnt > 0u ? cnt : 1u;
}

__device__ __forceinline__ void xcd_barrier(const XcdBarrier& b) {
    asm volatile("s_waitcnt vmcnt(0)" ::: "memory");
    __syncthreads();
    if (threadIdx.x == 0) {
        unsigned* bar = b.bar;
        __builtin_amdgcn_s_waitcnt(0);
        unsigned nloc = b.st[0], nx = b.st[1];
        if (nloc == 0u) { xcd_barrier_complete(bar, b.x, nloc, nx); b.st[0] = nloc; b.st[1] = nx; }
        const unsigned old = xb_add(&bar[XB_XSUB(b.x)], 1u);
        const unsigned gen = old / nloc;
        if (old + 1u == (gen + 1u) * nloc) {
            __builtin_amdgcn_fence(__ATOMIC_RELEASE, "agent");
            asm volatile("s_waitcnt vmcnt(0)" ::: "memory");
            const unsigned og = xb_add(&bar[XB_TOP], 1u);
            const unsigned tg = og / nx;
            if (og + 1u == (tg + 1u) * nx) xb_add(&bar[XB_TOPGEN], 1u);
            else XB_SPIN(xb_ld(&bar[XB_TOPGEN]) == tg, bar);
            __builtin_amdgcn_fence(__ATOMIC_ACQUIRE, "agent");
            xb_add(&bar[XB_XGEN(b.x)], 1u);
            asm volatile("s_waitcnt vmcnt(0)" ::: "memory");
        } else {
            XB_SPIN(xb_ld(&bar[XB_XGEN(b.x)]) == gen, bar);
            __builtin_amdgcn_fence(__ATOMIC_ACQUIRE, "agent");
            asm volatile("s_waitcnt vmcnt(0)" ::: "memory");
        }
    }
    __syncthreads();
}


#define KARG_ ((const unsigned char __attribute__((address_space(4)))*)__builtin_amdgcn_kernarg_segment_ptr())
#define IN_(i) (*(const float* const __attribute__((address_space(4)))*)(KARG_ + 8 * (i)))
#define OUT_ (*(float* const __attribute__((address_space(4)))*)(KARG_ + 144))
#define WSP_ (*(unsigned char* const __attribute__((address_space(4)))*)(KARG_ + 152))
struct Args { const float* in[18]; float* out; unsigned char* ws; int cg_sync; int pad; };
__global__ void __launch_bounds__(NTHR, 2) yoco_fwd(Args args) {
    extern __shared__ __attribute__((aligned(16))) unsigned char lds_raw[];
    LAS unsigned char* lds = (LAS unsigned char*)lds_raw;
    cg::grid_group grid = cg::this_grid();
    if (threadIdx.x < 256) ((LAS unsigned*)(lds + 131072))[threadIdx.x] = 0u;
    __syncthreads();
    const XcdBarrier xbar = xcd_barrier_post((unsigned*)WSP_, (volatile LAS unsigned*)(lds + 131072));
    const int tid = threadIdx.x, lane = tid & 63, wave = __builtin_amdgcn_readfirstlane(tid >> 6);
    const int G = gridDim.x, bx = blockIdx.x;
    const int gw = bx * NWAVES + wave, ngw = G * NWAVES;
#define WSB(off) ((bf16*)(WSP_ + (off)))
#define GEMM(KC, Aptr, Bptr, Mm, Nn, cid, Optr, ldo, scl, from, md, rsp, rsm) do { pg8::Gemm g_{(const pg8::bf16_t*)(Aptr), (const pg8::bf16_t*)(Bptr), (Mm), (Nn), (KC)}; pg8::StaticOrder S_; S_.init((Mm), (Nn), G, (cid)); \
        pg8::EpiU E_{(pg8::bf16_t*)(Optr), (ldo), (scl), (from), (md), (rsp), (rsm)}; pg8::gemm_phase<pg8::EpiU, pg8::StaticOrder, true, true, (KC)>(lds, g_, S_, E_); if (DUP_GEMM > 1) { asm volatile("" ::: "memory"); pg8::gemm_phase<pg8::EpiU, pg8::StaticOrder, true, true, (KC)>(lds, g_, S_, E_); } } while (0)
#define ROWS(XIB, XOB, xin, xout, gf, coef, rso) do { OPQ_IDS for (int m = gw; m < M; m += ROWS_R * ngw) row_jobs<ROWS_R, XIB, XOB>((xin), WSB(WS_XN), (gf), (coef), (xout), (const float*)nullptr, (bf16*)nullptr, (const float*)nullptr, (bf16*)nullptr, m, ngw, lane, (rso)); } while (0)
#define RS_ ((float*)(WSP_ + WS_RS))
#define XB_ ((bf16*)OUT_ + (size_t)M * D)
#define XB2_ WSB(WS_Y)
#define GSYNC() do { xcd_barrier(xbar); if (DUP_SYNC > 1) xcd_barrier(xbar); } while (0)
#define DUPX(n, ...) do { OPQ_IDS __VA_ARGS__; if ((n) > 1) { asm volatile("" ::: "memory"); __VA_ARGS__; } if ((n) > 2) { asm volatile("" ::: "memory"); __VA_ARGS__; } } while (0)
#define OPQ_IDS int tid_o = threadIdx.x; asm volatile("" : "+v"(tid_o)); tid_o &= 511; const int tid = tid_o, lane = tid_o & 63; (void)tid; (void)lane;
#define NORMG(l, k) (IN_(5) + ((l) * 6 + (k)) * D)
    constexpr int NOSC = 1 << 30;
    for (int rep_ = 0; rep_ < DUP_PRO; ++rep_) {
        OPQ_IDS
        LAS float* scr = (LAS float*)(lds + wave * 16384);
        constexpr int I_FF = 16 * 88, I_DN = 44 * 32, I_AIN = 16 * 56, I_BIN = 16 * 32, I_KV = 16 * 48, I_MIX = 16 * 32, I_MKV = 16 * 16;
        constexpr int NITEMS = 12 * I_FF + I_AIN + I_BIN + I_KV + 2 * I_MIX + 2 * I_MKV;
        static_assert(I_FF == I_DN, "item counts");
        for (int it = gw; it < NITEMS; it += ngw) {
            int r = it; const float* W; int K = D, N = D, mode = 0; bf16* WT; const float* gk = nullptr;
            if (r < 4 * I_FF) { const int sub = r / I_FF; W = IN_(2) + (size_t)sub * D * FF; N = FF; WT = WSB(WS_WGU) + (size_t)sub * 2 * FF * D; mode = 1; r %= I_FF; gk = NORMG(sub >> 1, (sub & 1) ? 4 : 0); }
            else if ((r -= 4 * I_FF) < 4 * I_FF) { const int sub = r / I_FF; W = IN_(3) + (size_t)sub * D * FF; N = FF; WT = WSB(WS_WGU) + (size_t)sub * 2 * FF * D; mode = 2; r %= I_FF; gk = NORMG(sub >> 1, (sub & 1) ? 4 : 0); }
            else if ((r -= 4 * I_FF) < 4 * I_DN) { const int sub = r / I_DN; W = IN_(4) + (size_t)sub * FF * D; K = FF; WT = WSB(WS_WD) + (size_t)sub * D * FF; r %= I_DN; }
            else if ((r -= 4 * I_DN) < I_AIN) { W = IN_(9); N = PROJ_LD; WT = WSB(WS_WAIN); gk = NORMG(0, 2); }
            else if ((r -= I_AIN) < I_BIN) { W = IN_(15); WT = WSB(WS_WBIN); gk = NORMG(1, 2); }
            else if ((r -= I_BIN) < I_KV) { W = IN_(17); N = 2 * RW; WT = WSB(WS_WKV); gk = IN_(16); }
            else if ((r -= I_KV) < 2 * I_MIX) { const int sub = r / I_MIX; W = IN_(8) + (size_t)sub * D * D; WT = WSB(WS_WMIX) + (size_t)sub * D * D; r %= I_MIX; }
            else { r -= 2 * I_MIX; const int sub = r / I_MKV; W = IN_(7) + (size_t)sub * D * 512; N = 512; WT = WSB(WS_Z) + (size_t)(1024 + sub * 512) * D; r %= I_MKV; }
            tr_item(W, K, N, WT, mode, 0, scr, r, lane, gk);
        }
        for (int idx = gw * 64 + lane; idx < 12 * 128 * 64; idx += ngw * 64) { const int in_ = idx & 63, row = (idx >> 6) & 127, nn = idx >> 13, g_ = row >> 6, out_ = row & 63;
            WSB(WS_GWT)[idx] = f2bf(IN_(12)[((size_t)(g_ * NBLK + nn) * 64 + in_) * 64 + out_]); }
        for (int j = gw; j < 1024; j += ngw) { const int l = j >> 9, rr = j & 511; row_job(IN_(1) + (size_t)rr * D, nullptr, nullptr, 0.f, nullptr, IN_(6) + l * D, WSB(WS_Z) + (size_t)j * D, nullptr, nullptr, lane); }
        for (int m = gw; m < M; m += ROWS_R * ngw) row_jobs<ROWS_R, false, true>(IN_(0), (const bf16*)nullptr, (const float*)nullptr, 0.f, XB_, (const float*)nullptr, (bf16*)nullptr, (const float*)nullptr, (bf16*)nullptr, m, ngw, lane, RS_);
    }
    if (*(const int __attribute__((address_space(4)))*)(KARG_ + 160)) grid.sync();
    GSYNC();
    GEMM(D, XB_, WSB(WS_WGU), M, 2 * FF, bx, WSB(WS_H), FF, 1.0f, NOSC, 1, RS_, 1);
    GSYNC();
    GEMM(FF, WSB(WS_H), WSB(WS_WD), M, D, bx, WSB(WS_XN), D, 1.0f, NOSC, 0, (const float*)nullptr, 0);
    GSYNC();
    ROWS(false, true, IN_(0), XB_, NORMG(0, 1), 0.5f, RS_);
    GSYNC();
    GEMM(D, XB_, WSB(WS_WAIN), M, PROJ_LD, bx, WSB(WS_H), PROJ_LD, QSCALE, 6, 0, RS_, 1);
    GEMM(D, WSB(WS_Z), WSB(WS_Z), 2048, 2048, (bx + 64) % G, WSB(WS_CZ), 2048, 1.0f, NOSC, 0, (const float*)nullptr, 0);
    GSYNC();
    { OPQ_IDS for (int u = bx; u < NB * NCHUNK * NBLK; u += G) scan_a_unit(lds, WSB(WS_H), IN_(10), IN_(11), WSB(WS_GWT), IN_(13), IN_(14), WSB(WS_KV), WSB(WS_KV) + (size_t)M * RW, (float*)(WSP_ + WS_AGG), u, tid); }
    if (DUP_SA > 1) { asm volatile("" ::: "memory"); for (int u = bx; u < NB * NCHUNK * NBLK; u += G) scan_a_unit(lds, WSB(WS_H), IN_(10), IN_(11), WSB(WS_GWT), IN_(13), IN_(14), WSB(WS_KV), WSB(WS_KV) + (size_t)M * RW, (float*)(WSP_ + WS_AGG), u, tid); }
    if (DUP_SA > 2) { asm volatile("" ::: "memory"); for (int u = bx; u < NB * NCHUNK * NBLK; u += G) scan_a_unit(lds, WSB(WS_H), IN_(10), IN_(11), WSB(WS_GWT), IN_(13), IN_(14), WSB(WS_KV), WSB(WS_KV) + (size_t)M * RW, (float*)(WSP_ + WS_AGG), u, tid); }
    GSYNC();
    DUPX(DUP_SC, for (int u = bx; u < NB * NCHUNK * NBLK; u += G) scan_c_unit(lds, WSB(WS_H), WSB(WS_KV), WSB(WS_KV) + (size_t)M * RW, (const float*)(WSP_ + WS_AGG), WSB(WS_Y), u, tid));
    mem_attn_phase(lds, WSB(WS_H), PROJ_LD, 2 * RW, WSB(WS_CZ), 0, WSB(WS_Y), bx, G, tid);
    GSYNC();
    GEMM(D, WSB(WS_Y), WSB(WS_WMIX), M, D, bx, WSB(WS_XN), D, 1.0f, NOSC, 0, (const float*)nullptr, 0);
    GSYNC();
    ROWS(true, true, XB_, XB_, NORMG(0, 3), 1.0f, RS_);
    GSYNC();
    GEMM(D, XB_, WSB(WS_WGU) + (size_t)1 * 2 * FF * D, M, 2 * FF, bx, WSB(WS_H), FF, 1.0f, NOSC, 1, RS_, 1);
    GSYNC();
    GEMM(FF, WSB(WS_H), WSB(WS_WD) + (size_t)1 * D * FF, M, D, bx, WSB(WS_XN), D, 1.0f, NOSC, 0, (const float*)nullptr, 0);
    GSYNC();
    ROWS(true, true, XB_, XB_, NORMG(0, 5), 0.5f, RS_);
    GSYNC();
    GEMM(D, XB_, WSB(WS_WKV), M, RW, bx, WSB(WS_KV), RW, 1.0f, NOSC, 0, RS_, 1);
    GEMM(D, WSB(WS_WKV) + (size_t)RW * D, XB_, RW, M, (bx + G / 2) % G, WSB(WS_KV) + (size_t)M * RW, M, 1.0f, NOSC, 0, RS_, 2);
    GEMM(D, XB_, WSB(WS_WGU) + (size_t)2 * 2 * FF * D, M, 2 * FF, bx, WSB(WS_H), FF, 1.0f, NOSC, 1, RS_, 1);
    GSYNC();
    GEMM(FF, WSB(WS_H), WSB(WS_WD) + (size_t)2 * D * FF, M, D, bx, WSB(WS_XN), D, 1.0f, NOSC, 0, (const float*)nullptr, 0);
    GSYNC();
    ROWS(true, true, XB_, XB_, NORMG(1, 1), 0.5f, RS_);
    GSYNC();
    GEMM(D, XB_, WSB(WS_WBIN), M, D, bx, WSB(WS_H), D, QSCALE, 0, 0, RS_, 1);
    GSYNC();
    DUPX(DUP_SB, for (int u = gw; u < NB * NH * 512; u += ngw) sb_attn_unit(WSB(WS_H), WSB(WS_KV), WSB(WS_KV) + (size_t)M * RW, WSB(WS_Y), u, lane));
    mem_attn_phase(lds, WSB(WS_H), D, RW, WSB(WS_CZ), 1, WSB(WS_Y), bx, G, tid);
    GSYNC();
    GEMM(D, WSB(WS_Y), WSB(WS_WMIX) + (size_t)D * D, M, D, bx, WSB(WS_XN), D, 1.0f, NOSC, 0, (const float*)nullptr, 0);
    GSYNC();
    ROWS(true, true, XB_, XB2_, NORMG(1, 3), 1.0f, RS_);
    GSYNC();
    GEMM(D, XB2_, WSB(WS_WGU) + (size_t)3 * 2 * FF * D, M, 2 * FF, bx, WSB(WS_H), FF, 1.0f, NOSC, 1, RS_, 1);
    GSYNC();
    GEMM(FF, WSB(WS_H), WSB(WS_WD) + (size_t)3 * D * FF, M, D, bx, WSB(WS_XN), D, 1.0f, NOSC, 0, (const float*)nullptr, 0);
    GSYNC();
    ROWS(true, false, XB2_, OUT_, NORMG(1, 5), 0.5f, (float*)nullptr);
}

#undef IN_
#undef XB_
#undef RS_
#undef XB2_
#undef OUT_
#undef WSP_
extern "C" void kernel_launch(void* const* d_in, const int* in_sizes, int n_in, void* d_out, int out_size, void* d_ws, size_t ws_size, hipStream_t stream) {
    static int grid = 0;
    if (grid == 0) {
        if (n_in != 18 || out_size != M * D || ws_size < WS_END) { fprintf(stderr, "kernel_launch: unexpected shapes (n_in %d out %d ws %zu)\n", n_in, out_size, ws_size); grid = -1; return; }
        int dev = 0, cus = 0, per_cu = 0;
        hipGetDevice(&dev); hipDeviceGetAttribute(&cus, hipDeviceAttributeMultiprocessorCount, dev);
        if (hipFuncSetAttribute((const void*)yoco_fwd, hipFuncAttributeMaxDynamicSharedMemorySize, LDS_BYTES) != hipSuccess) { fprintf(stderr, "kernel_launch: hipFuncSetAttribute failed\n"); grid = -1; return; }
        if (hipOccupancyMaxActiveBlocksPerMultiprocessor(&per_cu, (const void*)yoco_fwd, NTHR, LDS_BYTES) != hipSuccess || per_cu < 1) { fprintf(stderr, "kernel_launch: occupancy query says %d\n", per_cu); per_cu = 1; }
        (void)hipGetLastError();
        grid = cus;
    }
    if (grid < 0) return;
    if (hipMemsetAsync(d_ws, 0, XCD_BAR_WORDS * 4, stream) != hipSuccess) { fprintf(stderr, "kernel_launch: memset of the barrier words failed\n"); return; }
    Args a{};
    for (int i = 0; i < 18; ++i) a.in[i] = (const float*)d_in[i];
    a.out = (float*)d_out; a.ws = (unsigned char*)d_ws;
    void* kargs[] = {&a};
    hipError_t e = hipLaunchCooperativeKernel((const void*)yoco_fwd, dim3(grid), dim3(NTHR), kargs, LDS_BYTES, stream);
    if (e != hipSuccess) fprintf(stderr, "kernel_launch: cooperative launch failed: %s (grid %d)\n", hipGetErrorString(e), grid);
}
```
